# Optimizing an MI355X kernel written in HIP

```python
import jax, jax.numpy as jnp
from jax import lax
import numpy as np

D_MODEL = 1024
BATCH = 16
SEQ = 2048
DEPTH = 2

N_MIXERS = 2
MEM_LEN = 256
EPS = 1e-6
HG_HEADS = 8
HG_DIM = D_MODEL // HG_HEADS
HG_WIDTH = HG_HEADS * HG_DIM
HG_CHUNK = 64
GM_CHUNK = 128
GM_GROUPS = 8
GM_WIDTH = 2 * D_MODEL
GM_GROUP_DIM = GM_WIDTH // GM_GROUPS
XA_HEADS = 4
XA_DIM = D_MODEL // XA_HEADS
XA_WIDTH = XA_HEADS * XA_DIM
D_FF = 2816
N_HGRN = (DEPTH + 1) // 2
N_GMLP = DEPTH // 2
HG_IN = 4 * HG_WIDTH + XA_WIDTH
GM_IN = 2 * GM_WIDTH + XA_WIDTH

kernel_name = "hybrid_hgrn2_gmlp_memory_macaron"


def rmsnorm(x, g):
    xf = x.astype(jnp.float32)
    y = xf * lax.rsqrt(jnp.mean(xf * xf, axis=-1, keepdims=True) + EPS)
    return (y * g.astype(jnp.float32)).astype(x.dtype)


def layernorm(x, g, b):
    xf = x.astype(jnp.float32)
    mu = jnp.mean(xf, axis=-1, keepdims=True)
    xc = xf - mu
    y = xc * lax.rsqrt(jnp.mean(xc * xc, axis=-1, keepdims=True) + EPS)
    return (y * g.astype(jnp.float32) + b.astype(jnp.float32)).astype(x.dtype)


def swiglu_ffn(h, w_in, w_out):
    gate, up = jnp.split(h @ w_in, 2, axis=-1)
    return (jax.nn.silu(gate) * up) @ w_out


def memory_attention(zq, mem_k, mem_v):
    B, T, _ = zq.shape
    q = zq.reshape(B, T, XA_HEADS, XA_DIM)
    s = jnp.einsum('bthd,bmhd->bhtm', q, mem_k).astype(jnp.float32) * (XA_DIM ** -0.5)
    p = jax.nn.softmax(s, axis=-1).astype(mem_v.dtype)
    o = jnp.einsum('bhtm,bmhd->bthd', p, mem_v)
    return o.reshape(B, T, XA_WIDTH)


def hgrn2_recurrence(q, k, v, log_f):
    B, T, H, Dk = q.shape
    Dv = v.shape[-1]
    n = T // HG_CHUNK

    def to_chunks(a):
        return a.reshape(B, n, HG_CHUNK, H, a.shape[-1]).transpose(1, 0, 3, 2, 4)

    qc, kc, vc, lc = to_chunks(q), to_chunks(k), to_chunks(v), to_chunks(log_f)
    causal = jnp.tril(jnp.ones((HG_CHUNK, HG_CHUNK), dtype=bool))

    def step(S, inp):
        qn, kn, vn, ln = inp
        b = jnp.cumsum(ln, axis=2)
        b_last = b[:, :, -1:, :]
        q_dec = qn * jnp.exp(b)
        k_inv = kn * jnp.exp(-b)
        a = jnp.einsum('bhtk,bhsk->bhts', q_dec, k_inv)
        a = jnp.where(causal, a, 0.0)
        o = jnp.einsum('bhts,bhsv->bhtv', a, vn) + jnp.einsum('bhtk,bhkv->bhtv', q_dec, S)
        S_new = jnp.exp(b_last[:, :, 0, :])[..., None] * S + jnp.einsum(
            'bhsk,bhsv->bhkv', kn * jnp.exp(b_last - b), vn)
        return S_new, o

    S0 = jnp.zeros((B, H, Dk, Dv), jnp.float32)
    _, o = lax.scan(step, S0, (qc, kc, vc, lc))
    return o.transpose(1, 0, 3, 2, 4).reshape(B, T, H, Dv)


def hgrn2_mixer(zq, zf, zi, zg, lb, gnorm_g):
    B, T, _ = zq.shape
    shp = (B, T, HG_HEADS, HG_DIM)
    q = jax.nn.silu(zq.astype(jnp.float32)).reshape(shp)
    lbh = lb.astype(jnp.float32).reshape(HG_HEADS, HG_DIM)
    f = lbh + (1.0 - lbh) * jax.nn.sigmoid(zf.astype(jnp.float32).reshape(shp))
    k = 1.0 - f
    v = zi.astype(jnp.float32).reshape(shp)
    o = hgrn2_recurrence(q, k, v, jnp.log(f))
    o = rmsnorm(o, gnorm_g) * jax.nn.silu(zg.astype(jnp.float32).reshape(shp))
    return o.reshape(B, T, HG_WIDTH).astype(zq.dtype)


def chunked_spatial_gating(zu, zv, ln_g, ln_b, w_s, b_s):
    B, T, _ = zu.shape
    n = T // GM_CHUNK
    u = jax.nn.gelu(zu, approximate=False)
    v = layernorm(jax.nn.gelu(zv, approximate=False), ln_g, ln_b)
    vc = v.reshape(B, n, GM_CHUNK, GM_GROUPS, GM_GROUP_DIM)
    causal = jnp.tril(jnp.ones((GM_CHUNK, GM_CHUNK), dtype=bool))
    w = jnp.where(causal[None], w_s, 0.0).astype(v.dtype)
    mixed = jnp.einsum('gts,bnsgc->bntgc', w, vc) + b_s.T.astype(v.dtype)[None, None, :, :, None]
    return u * mixed.reshape(B, T, GM_WIDTH)


def setup_inputs(seed: int = 0) -> dict:
    key = jax.random.key(seed)
    ks = iter(jax.random.split(key, 32))

    def nrm(shape, scale):
        return jax.random.normal(next(ks), shape, jnp.float32) * scale

    def gain(shape):
        return 1.0 + nrm(shape, 0.05)

    return {
        "x": nrm((BATCH, SEQ, D_MODEL), 1.0),
        "mem": nrm((BATCH, MEM_LEN, D_MODEL), 1.0),
        "mem_norm": gain((D_MODEL,)),
        "lb_logits": nrm((DEPTH + 1, HG_WIDTH), 0.1),
        "ffn1_norm": gain((DEPTH, D_MODEL)),
        "ffn1_w_in": nrm((DEPTH, D_MODEL, 2 * D_FF), D_MODEL ** -0.5),
        "ffn1_w_out": nrm((DEPTH, D_FF, D_MODEL), D_FF ** -0.5),
        "mix_norm": gain((DEPTH, D_MODEL)),
        "mem_w_kv": nrm((DEPTH, D_MODEL, 2 * XA_WIDTH), D_MODEL ** -0.5),
        "hgrn_w_in": nrm((N_HGRN, D_MODEL, HG_IN), D_MODEL ** -0.5),
        "hgrn_gnorm": gain((N_HGRN, HG_DIM)),
        "hgrn_w_out": nrm((N_HGRN, HG_WIDTH + XA_WIDTH, D_MODEL), (HG_WIDTH + XA_WIDTH) ** -0.5),
        "gmlp_w_in": nrm((N_GMLP, D_MODEL, GM_IN), D_MODEL ** -0.5),
        "gmlp_ln_g": gain((N_GMLP, GM_WIDTH)),
        "gmlp_ln_b": nrm((N_GMLP, GM_WIDTH), 0.02),
        "gmlp_w_s": nrm((N_GMLP, GM_GROUPS, GM_CHUNK, GM_CHUNK), GM_CHUNK ** -0.5),
        "gmlp_b_s": 1.0 + nrm((N_GMLP, GM_GROUPS, GM_CHUNK), 0.1),
        "gmlp_w_out": nrm((N_GMLP, GM_WIDTH + XA_WIDTH, D_MODEL), (GM_WIDTH + XA_WIDTH) ** -0.5),
        "ffn2_norm": gain((DEPTH, D_MODEL)),
        "ffn2_w_in": nrm((DEPTH, D_MODEL, 2 * D_FF), D_MODEL ** -0.5),
        "ffn2_w_out": nrm((DEPTH, D_FF, D_MODEL), D_FF ** -0.5),
        "final_norm": gain((D_MODEL,)),
    }


def reference(x, mem, mem_norm, lb_logits, ffn1_norm, ffn1_w_in, ffn1_w_out, mix_norm, mem_w_kv,
              hgrn_w_in, hgrn_gnorm, hgrn_w_out, gmlp_w_in, gmlp_ln_g, gmlp_ln_b, gmlp_w_s, gmlp_b_s,
              gmlp_w_out, ffn2_norm, ffn2_w_in, ffn2_w_out, final_norm):
    B, T, _ = x.shape
    M = mem.shape[1]
    mem_n = rmsnorm(mem, mem_norm)
    lower_bounds = jnp.cumsum(jax.nn.softmax(lb_logits.astype(jnp.float32), axis=0), axis=0)

    for i in range(DEPTH):
        x = x + 0.5 * swiglu_ffn(rmsnorm(x, ffn1_norm[i]), ffn1_w_in[i], ffn1_w_out[i])

        h = rmsnorm(x, mix_norm[i])
        mk, mv = jnp.split(mem_n @ mem_w_kv[i], 2, axis=-1)
        mk = mk.reshape(B, M, XA_HEADS, XA_DIM)
        mv = mv.reshape(B, M, XA_HEADS, XA_DIM)
        j = i // N_MIXERS
        if i % N_MIXERS == 0:
            z = h @ hgrn_w_in[j]
            zq, zf, zi, zg, zx = jnp.split(z, [HG_WIDTH, 2 * HG_WIDTH, 3 * HG_WIDTH, 4 * HG_WIDTH], axis=-1)
            o_mix = hgrn2_mixer(zq, zf, zi, zg, lower_bounds[i], hgrn_gnorm[j])
            w_out = hgrn_w_out[j]
        else:
            z = h @ gmlp_w_in[j]
            zu, zv, zx = jnp.split(z, [GM_WIDTH, 2 * GM_WIDTH], axis=-1)
            o_mix = chunked_spatial_gating(zu, zv, gmlp_ln_g[j], gmlp_ln_b[j], gmlp_w_s[j], gmlp_b_s[j])
            w_out = gmlp_w_out[j]
        o_mem = memory_attention(zx, mk, mv)
        x = x + jnp.concatenate([o_mix, o_mem], axis=-1) @ w_out

        x = x + 0.5 * swiglu_ffn(rmsnorm(x, ffn2_norm[i]), ffn2_w_in[i], ffn2_w_out[i])

    return rmsnorm(x, final_norm)
```

```cpp
#include <hip/hip_runtime.h>
#include <hip/hip_cooperative_groups.h>
#include <cstdio>
#include <cstdint>
namespace cg = cooperative_groups;

#define LAS __attribute__((address_space(3)))
typedef unsigned short bf16_t;
typedef short bf16x8 __attribute__((ext_vector_type(8)));
typedef float f32x4 __attribute__((ext_vector_type(4)));
typedef float f32x2 __attribute__((ext_vector_type(2)));
typedef unsigned u32x4 __attribute__((ext_vector_type(4)));
typedef unsigned u32x2 __attribute__((ext_vector_type(2)));

constexpr int NB = 16, T = 2048, D = 1024, M = NB * T, FF = 2816, ZW = 5120, MEM = 256, MROWS = NB * MEM;
constexpr float EPS = 1e-6f;
constexpr int NTHREADS = 512;
constexpr int LDS_BYTES = 147456;

constexpr size_t MiB = 1u << 20;
constexpr size_t WS_PART = 0;
constexpr size_t WS_STAT = 2 * MiB;
constexpr size_t WS_WM = 10 * MiB;
constexpr size_t WS_MEMN = 11 * MiB;
constexpr size_t WS_KB = 19 * MiB;
constexpr size_t WS_W1IN = 35 * MiB;
constexpr size_t WS_W1OUT = 46 * MiB;
constexpr size_t WS_W2IN = 52 * MiB;
constexpr size_t WS_W2OUT = 63 * MiB;
constexpr size_t WS_WKV = 69 * MiB;
constexpr size_t WS_WIN = 73 * MiB;
constexpr size_t WS_WOUT = 83 * MiB;
constexpr size_t WS_XB = 90 * MiB;
constexpr size_t WS_Z = 154 * MiB;
constexpr size_t WS_CTL = 474 * MiB;
constexpr size_t WS_VT = 475 * MiB;
constexpr size_t WS_W2IN1 = 483 * MiB;
constexpr size_t WS_W2OUT1 = 494 * MiB;
constexpr size_t WS_WOUT1 = 500 * MiB;
constexpr size_t WS_END = 506 * MiB;

typedef __bf16 bf16x2_t __attribute__((ext_vector_type(2)));
__device__ __forceinline__ unsigned pk2(float lo, float hi) { f32x2 v = {lo, hi}; bf16x2_t r = __builtin_convertvector(v, bf16x2_t); return __builtin_bit_cast(unsigned, r); }
__device__ __forceinline__ float bf2f(unsigned short b) { return __uint_as_float(((unsigned)b) << 16); }
__device__ __forceinline__ float bflo(unsigned w) { return __uint_as_float(w << 16); }
__device__ __forceinline__ float bfhi(unsigned w) { return __uint_as_float(w & 0xffff0000u); }
__device__ __forceinline__ float fast_rcp(float x) { return __builtin_amdgcn_rcpf(x); }
__device__ __forceinline__ float silu_f(float x) { return x * fast_rcp(1.0f + __expf(-x)); }
__device__ __forceinline__ float shx(float v, int mask, int lane) { return __builtin_bit_cast(float, __builtin_amdgcn_ds_bpermute((lane ^ mask) << 2, __builtin_bit_cast(int, v))); }
__device__ __forceinline__ float wave_sum(float v, int lane) {
#pragma unroll
    for (int o = 1; o < 64; o <<= 1) v += shx(v, o, lane);
    return v;
}
__device__ __forceinline__ int lane_id() { int r; asm volatile("v_mbcnt_lo_u32_b32 %0, -1, 0\n\tv_mbcnt_hi_u32_b32 %0, -1, %0" : "=v"(r)); return r; }
__device__ __forceinline__ int opaque_vv(int x) { asm volatile("" : "+v"(x)); return x; }
__device__ __forceinline__ int opaque_s(int x) { asm volatile("" : "+s"(x)); return x; }
#define WG_BAR() do { asm volatile("s_waitcnt lgkmcnt(0)" ::: "memory"); __builtin_amdgcn_s_barrier(); asm volatile("" ::: "memory"); } while (0)
#define LDS_WAIT() asm volatile("s_waitcnt lgkmcnt(0)" ::: "memory")
#define VM_WAIT() asm volatile("s_waitcnt vmcnt(0)" ::: "memory")
__device__ __forceinline__ f32x4 mfma16(bf16x8 x, bf16x8 y, f32x4 acc) { return __builtin_amdgcn_mfma_f32_16x16x32_bf16(x, y, acc, 0, 0, 0); }

__device__ __forceinline__ float gelu_f(float v) {
    const float av = fabsf(v), d = av * 0.2316418882f + 1.0f;
    const float t = fast_rcp(d);
    float q = t * 0.5307027145f + (-0.7265760135f); q = q * t + 0.7107068705f; q = q * t + (-0.142248368f); q = q * t + 0.127414796f; q = q * t;
    const float e = __builtin_amdgcn_exp2f((v * v) * (-0.72134752044f));
    const float m = v * (q * e), r = v - m;
    return v < 0.f ? m : r;
}

__device__ __forceinline__ f32x2 sigmoid_pk(f32x2 x) {
    const f32x2 xc = __builtin_elementwise_max(x, (f32x2){-30.f, -30.f});
    const f32x2 t = xc * (-1.4426950408889634f);
    f32x2 e; e.x = __builtin_amdgcn_exp2f(t.x); e.y = __builtin_amdgcn_exp2f(t.y);
    const f32x2 d = e + 1.0f;
    const float r = fast_rcp(d.x * d.y);
    return (f32x2){r * d.y, r * d.x};
}
__device__ __forceinline__ f32x2 gelu_pk(f32x2 v) {
    const f32x2 av = __builtin_elementwise_abs(v), d = av * 0.2316418882f + 1.0f;
    f32x2 t; t.x = fast_rcp(d.x); t.y = fast_rcp(d.y);
    f32x2 q = t * 0.5307027145f + (-0.7265760135f); q = q * t + 0.7107068705f; q = q * t + (-0.142248368f); q = q * t + 0.127414796f; q = q * t;
    const f32x2 sq = (v * v) * (-0.72134752044f);
    f32x2 e; e.x = __builtin_amdgcn_exp2f(sq.x); e.y = __builtin_amdgcn_exp2f(sq.y);
    const f32x2 m = v * (q * e), r = v - m;
    f32x2 o; o.x = v.x < 0.f ? m.x : r.x; o.y = v.y < 0.f ? m.y : r.y; return o;
}

namespace pg8 {
constexpr int BM = 256, BK = 64, HALF = 128, HTB = HALF * BK * 2, STAGE_BYTES = 8 * HTB, NXCD = 8, WGM = 8;
__host__ __device__ __forceinline__ int lds_byte(int r, int c) { const int st = (r >> 4) * 2 + (c >> 5), rr = r & 15, cc = c & 31, ob = rr * 64 + cc * 2; return st * 1024 + (ob ^ (((ob >> 9) & 1) << 5)); }
__host__ __device__ __forceinline__ void stage_rc(int b, int& R, int& C) { const int st = b / 1024, sb = b % 1024, swz = sb ^ (((sb >> 9) & 1) << 5); R = (st >> 1) * 16 + swz / 64; C = (st & 1) * 32 + (swz % 64) / 2; }
__host__ __device__ __forceinline__ int perm32(int rho) { const int n = rho >> 4, i = rho & 15; return 8 * (i >> 2) + 4 * n + (i & 3); }

struct Unit { int pm, pn; };
struct Gemm { const bf16_t* A; const bf16_t* Bt; int lda, ldb, K; };

struct StaticOrder {
    int nM, nN, nwg, G, c;
    __device__ void init(int M_, int N_, int G_, int c_) { nM = M_ / BM; nN = N_ / BM; nwg = nM * nN; G = G_; c = c_; }
    __device__ bool next(int i, Unit& u) const {
        const long L = (long)i * G + c; if (L >= nwg) return false;
        int wgid = (int)L; { const int q = nwg / NXCD, r = nwg % NXCD, xcd = wgid % NXCD, off = wgid / NXCD; wgid = (xcd < r ? xcd * (q + 1) : r * (q + 1) + (xcd - r) * q) + off; }
        const int nig = WGM * nN, gid = wgid / nig, fm = gid * WGM, gsz = (nM - fm) < WGM ? (nM - fm) : WGM;
        u.pm = fm + ((wgid % nig) % gsz); u.pn = (wgid % nig) / gsz; return true;
    }
    __device__ __forceinline__ const char* aptr(const Gemm& g, const Unit& u) const { return (const char*)g.A + (size_t)u.pm * BM * g.lda * 2; }
    __device__ __forceinline__ const char* bptr(const Gemm& g, const Unit& u) const { return (const char*)g.Bt + (size_t)u.pn * BM * g.ldb * 2; }
};
struct FixedUnit {
    Unit u; bool has;
    __device__ bool next(int i, Unit& o) const { if (i != 0 || !has) return false; o = u; return true; }
    __device__ __forceinline__ const char* aptr(const Gemm& g, const Unit& v) const { return (const char*)g.A + (size_t)v.pm * BM * g.lda * 2; }
    __device__ __forceinline__ const char* bptr(const Gemm& g, const Unit& v) const { return (const char*)g.Bt + (size_t)v.pn * BM * g.ldb * 2; }
};
struct OneUnit {
    Unit u;
    __device__ bool next(int i, Unit& o) const { if (i != 0) return false; o = u; return true; }
    __device__ __forceinline__ const char* aptr(const Gemm& g, const Unit&) const { return (const char*)g.A; }
    __device__ __forceinline__ const char* bptr(const Gemm& g, const Unit&) const { return (const char*)g.Bt; }
};

template <class Epi, class Sched, bool ALIGN_EPI>
__device__ __forceinline__ void gemm_phase(LAS unsigned char* lds, const Gemm g, const Sched& S, const Epi& E, int wid0) {
    const int wid = opaque_s(wid0), lane = lane_id(), tid = wid * 64 + lane, wr = wid >> 2, wc = wid & 3, fr = lane & 15, fq = lane >> 4;
    const int K = g.K, nt = K / BK;
    unsigned voffA[2], voffB[2];
#pragma unroll
    for (int i = 0; i < 2; ++i) { int R, C; stage_rc(tid * 16 + i * 8192, R, C); const int Rb = Epi::PERM ? ((R & ~31) + perm32(R & 31)) : R;
        voffA[i] = (unsigned)(R * g.lda + C) * 2u; voffB[i] = (unsigned)(Rb * g.ldb + C) * 2u; }
    const size_t kstep = (size_t)(BK * 2);
    const size_t hstepA = (size_t)HALF * g.lda * 2, hstepB = (size_t)HALF * g.ldb * 2;
    const unsigned ldsw = (unsigned)wid * 1024u;
    const int aoff = lds_byte(wr * 64 + fr, fq * 8), boff = lds_byte(wc * 32 + fr, fq * 8);
#define PG8_SA(b, h) (((b) * 2 + (h)) * HTB)
#define PG8_SB(b, h) ((4 + (b) * 2 + (h)) * HTB)
#define PG8_STAGE(bufoff, gbase, voff) do { _Pragma("unroll") for (int _i = 0; _i < 2; ++_i) \
        __builtin_amdgcn_global_load_lds((const unsigned*)((const char*)(gbase) + (voff)[_i]), (LAS unsigned*)(lds + (bufoff) + ldsw + _i * 8192), 16, 0, 0); } while (0)
#define PG8_LDA(dst, b, h) do { _Pragma("unroll") for (int m = 0; m < 4; ++m) _Pragma("unroll") for (int k = 0; k < 2; ++k) dst[m][k] = *(const LAS bf16x8*)(lds + PG8_SA(b, h) + aoff + m * 2048 + k * 1024); } while (0)
#define PG8_LDB(dst, b, h) do { _Pragma("unroll") for (int n = 0; n < 2; ++n) _Pragma("unroll") for (int k = 0; k < 2; ++k) dst[n][k] = *(const LAS bf16x8*)(lds + PG8_SB(b, h) + boff + n * 2048 + k * 1024); } while (0)
#define PG8_MMA(ai, bj, At, Bt) do { __builtin_amdgcn_s_setprio(1); _Pragma("unroll") for (int m = 0; m < 4; ++m) _Pragma("unroll") for (int n = 0; n < 2; ++n) _Pragma("unroll") for (int k = 0; k < 2; ++k) \
        acc[ai][bj][m][n] = __builtin_amdgcn_mfma_f32_16x16x32_bf16(Bt[n][k], At[m][k], acc[ai][bj][m][n], 0, 0, 0); __builtin_amdgcn_s_setprio(0); } while (0)
#define PG8_WAIT_V(n) asm volatile("s_waitcnt vmcnt(" #n ")" ::: "memory")
#define PG8_WAIT_L(n) asm volatile("s_waitcnt lgkmcnt(" #n ")" ::: "memory")
#define PG8_BAR __builtin_amdgcn_s_barrier()
#define PG8_SCHED __builtin_amdgcn_sched_barrier(0)
    Unit cur, nxt; int ui = 0;
    if (!S.next(0, cur)) return;
    f32x4 acc[2][2][4][2];
#pragma unroll
    for (int a = 0; a < 2; ++a)
#pragma unroll
        for (int b = 0; b < 2; ++b)
#pragma unroll
            for (int m = 0; m < 4; ++m)
#pragma unroll
                for (int n = 0; n < 2; ++n) acc[a][b][m][n] = (f32x4){0.f, 0.f, 0.f, 0.f};
    bf16x8 At[4][2], B0[2][2], B1[2][2];
    const char* cA = S.aptr(g, cur); const char* cB = S.bptr(g, cur);
    PG8_STAGE(PG8_SB(0, 0), cB, voffB); PG8_STAGE(PG8_SB(0, 1), cB + hstepB, voffB); PG8_STAGE(PG8_SA(0, 0), cA, voffA); PG8_STAGE(PG8_SA(0, 1), cA + hstepA, voffA);
    if (wr == 1) PG8_BAR;
    PG8_WAIT_V(2); PG8_BAR;
    PG8_STAGE(PG8_SB(1, 0), cB + kstep, voffB); PG8_STAGE(PG8_SA(1, 0), cA + kstep, voffA); PG8_STAGE(PG8_SB(1, 1), cB + hstepB + kstep, voffB);
    PG8_WAIT_V(6); PG8_BAR;
    for (;;) {
        const bool has_next = S.next(ui + 1, nxt);
        const char* nA = has_next ? S.aptr(g, nxt) : cA; const char* nB = has_next ? S.bptr(g, nxt) : cB;
        for (int t = 0; t < nt; t += 2) {
            const bool last = (t == nt - 2);
            const char* a1 = cA + (size_t)(t + 1) * kstep;
            const char* a2 = last ? nA : cA + (size_t)(t + 2) * kstep; const char* b2 = last ? nB : cB + (size_t)(t + 2) * kstep;
            const char* a3 = a2 + kstep; const char* b3 = b2 + kstep;
            PG8_LDB(B0, 0, 0); PG8_LDB(B1, 0, 1); PG8_SCHED; PG8_LDA(At, 0, 0); PG8_STAGE(PG8_SA(1, 1), a1 + hstepA, voffA);
            PG8_WAIT_V(8); PG8_WAIT_L(0); PG8_BAR; PG8_MMA(0, 0, At, B0); PG8_MMA(0, 1, At, B1); PG8_BAR; PG8_SCHED;
            PG8_LDA(At, 0, 1); PG8_STAGE(PG8_SB(0, 0), b2, voffB); PG8_STAGE(PG8_SB(0, 1), b2 + hstepB, voffB); PG8_STAGE(PG8_SA(0, 0), a2, voffA);
            PG8_WAIT_V(8); PG8_WAIT_L(0); PG8_BAR; PG8_MMA(1, 0, At, B0); PG8_MMA(1, 1, At, B1); PG8_BAR; PG8_SCHED;
            PG8_LDB(B0, 1, 0); PG8_LDB(B1, 1, 1); PG8_SCHED; PG8_LDA(At, 1, 0); PG8_STAGE(PG8_SA(0, 1), a2 + hstepA, voffA);
            PG8_WAIT_V(8); PG8_WAIT_L(0); PG8_BAR; PG8_MMA(0, 0, At, B0); PG8_MMA(0, 1, At, B1); PG8_BAR; PG8_SCHED;
            PG8_LDA(At, 1, 1); PG8_STAGE(PG8_SB(1, 0), b3, voffB); PG8_STAGE(PG8_SB(1, 1), b3 + hstepB, voffB); PG8_STAGE(PG8_SA(1, 0), a3, voffA);
            PG8_WAIT_V(8); PG8_WAIT_L(0); PG8_BAR; PG8_MMA(1, 0, At, B0); PG8_MMA(1, 1, At, B1); PG8_BAR; PG8_SCHED;
        }
        if constexpr (ALIGN_EPI) { if (wr == 0) PG8_BAR; }
        if constexpr (!Epi::AFTER_DRAIN) { E(acc, cur, wr, wc, fr, fq); }
        if (!has_next) break;
#pragma unroll
        for (int a = 0; a < 2; ++a)
#pragma unroll
            for (int b = 0; b < 2; ++b)
#pragma unroll
                for (int m = 0; m < 4; ++m)
#pragma unroll
                    for (int n = 0; n < 2; ++n) acc[a][b][m][n] = (f32x4){0.f, 0.f, 0.f, 0.f};
        cur = nxt; cA = nA; cB = nB; ++ui;
        if constexpr (ALIGN_EPI) { if (wr == 1) PG8_BAR; }
    }
    PG8_WAIT_V(0);
    if constexpr (!ALIGN_EPI) { if (wr == 0) PG8_BAR; }
    PG8_BAR;
    if constexpr (Epi::AFTER_DRAIN) { E.fused(acc, cur, wr, wc, fr, fq, lds, wid, lane); }
#undef PG8_SA
#undef PG8_SB
#undef PG8_STAGE
#undef PG8_LDA
#undef PG8_LDB
#undef PG8_MMA
#undef PG8_WAIT_V
#undef PG8_WAIT_L
#undef PG8_BAR
#undef PG8_SCHED
}

__device__ __forceinline__ float row_rstd(const float* part, int r) {
    const f32x4* p = (const f32x4*)(part + (size_t)r * 16);
    const f32x4 a = p[0], b = p[1], c = p[2], d = p[3];
    const float s = ((a[0] + a[1]) + (a[2] + a[3])) + ((b[0] + b[1]) + (b[2] + b[3])) + ((c[0] + c[1]) + (c[2] + c[3])) + ((d[0] + d[1]) + (d[2] + d[3]));
    return 1.0f / sqrtf(s * (1.0f / 1024.0f) + EPS);
}

__device__ __forceinline__ void load_rstd8(const float* part, int row0, int fq, int lane, float (&rs)[8]) {
    f32x4 p[8];
#pragma unroll
    for (int i = 0; i < 8; ++i) p[i] = *(const f32x4*)(part + (size_t)(row0 + (i >> 2) * HALF + (i & 3) * 16) * 16 + fq * 4);
#pragma unroll
    for (int i = 0; i < 8; ++i) { float s = (p[i][0] + p[i][1]) + (p[i][2] + p[i][3]); s += shx(s, 16, lane); s += shx(s, 32, lane); rs[i] = __builtin_amdgcn_rsqf(s * (1.0f / 1024.0f) + EPS); }
}

struct EpiSwiglu {
    static constexpr bool PERM = true, AFTER_DRAIN = false;
    bf16_t* H; const float* part;
    __device__ __forceinline__ void operator()(const f32x4 (&acc)[2][2][4][2], const Unit& u, int wr, int wc, int fr, int fq) const {
        const int row0 = u.pm * BM + wr * 64 + fr, col0 = u.pn * 128 + wc * 32 + 8 * fq;
        float rsv[8]; load_rstd8(part, row0, fq, fq * 16 + fr, rsv);
#pragma unroll
        for (int ai = 0; ai < 2; ++ai)
#pragma unroll
            for (int m = 0; m < 4; ++m) {
                const int r = row0 + ai * HALF + m * 16; const float rs = rsv[ai * 4 + m];
                f32x2 h[4];
#pragma unroll
                for (int n = 0; n < 2; ++n)
#pragma unroll
                    for (int j = 0; j < 4; j += 2) {
                        const f32x2 gt = (f32x2){acc[ai][0][m][n][j], acc[ai][0][m][n][j + 1]} * rs, up = (f32x2){acc[ai][1][m][n][j], acc[ai][1][m][n][j + 1]} * rs;
                        h[n * 2 + (j >> 1)] = gt * sigmoid_pk(gt) * up;
                    }
                u32x4 w; w.x = pk2(h[0].x, h[0].y); w.y = pk2(h[1].x, h[1].y); w.z = pk2(h[2].x, h[2].y); w.w = pk2(h[3].x, h[3].y);
                __builtin_nontemporal_store(w, (u32x4*)(H + (size_t)r * ZW + col0));
            }
    }
};

struct EpiResid {
    static constexpr bool PERM = true, AFTER_DRAIN = false;
    const float* xin32; bf16_t* xb; float* part; float s;
    __device__ __forceinline__ void operator()(const f32x4 (&acc)[2][2][4][2], const Unit& u, int wr, int wc, int fr, int fq) const {
        const int row0 = u.pm * BM + wr * 64 + fr, col0 = u.pn * BM + wc * 32 + 8 * fq;
        u32x4 wx[2][4][2];
        if (!xin32) {
#pragma unroll
            for (int ai = 0; ai < 2; ++ai)
#pragma unroll
                for (int m = 0; m < 4; ++m)
#pragma unroll
                    for (int bj = 0; bj < 2; ++bj) wx[ai][m][bj] = *(const u32x4*)(xb + (size_t)(row0 + ai * HALF + m * 16) * D + col0 + bj * HALF);
            asm volatile("" ::: "memory");
        }
#pragma unroll
        for (int ai = 0; ai < 2; ++ai)
#pragma unroll
            for (int m = 0; m < 4; ++m) {
                const int r = row0 + ai * HALF + m * 16; float ss = 0.f;
#pragma unroll
                for (int bj = 0; bj < 2; ++bj) {
                    const size_t off = (size_t)r * D + col0 + bj * HALF;
                    f32x4 a, b;
                    if (xin32) { a = *(const f32x4*)(xin32 + off); b = *(const f32x4*)(xin32 + off + 4); }
                    else { const u32x4 w = wx[ai][m][bj]; a = (f32x4){bflo(w.x), bfhi(w.x), bflo(w.y), bfhi(w.y)}; b = (f32x4){bflo(w.z), bfhi(w.z), bflo(w.w), bfhi(w.w)}; }
                    a = a + acc[ai][bj][m][0] * s; b = b + acc[ai][bj][m][1] * s;
                    ss += (a[0] * a[0] + a[1] * a[1]) + (a[2] * a[2] + a[3] * a[3]) + (b[0] * b[0] + b[1] * b[1]) + (b[2] * b[2] + b[3] * b[3]);
                    u32x4 w2; w2.x = pk2(a[0], a[1]); w2.y = pk2(a[2], a[3]); w2.z = pk2(b[0], b[1]); w2.w = pk2(b[2], b[3]);
                    *(u32x4*)(xb + off) = w2;
                }
                ss += shx(ss, 16, (fq * 16 + fr)); ss += shx(ss, 32, (fq * 16 + fr));
                if (fq == 0) part[(size_t)r * 16 + u.pn * 4 + wc] = ss;
            }
    }
};

struct EpiZ {
    static constexpr bool PERM = true, AFTER_DRAIN = false;
    bf16_t* Z; const float* part; float* stat; int mode;
    __device__ __forceinline__ void operator()(const f32x4 (&acc)[2][2][4][2], const Unit& u, int wr, int wc, int fr, int fq) const {
        const int row0 = u.pm * BM + wr * 64 + fr, col0 = u.pn * BM + wc * 32 + 8 * fq;
        const int sec = u.pn >> 2;
        int act;
        if (mode == 0) act = (sec == 0 || sec == 4) ? 1 : (sec == 1 ? 3 : 0);
        else act = (sec == 2) ? 3 : 2;
        const bool dostat = (mode == 1) && (sec >= 3);
        float rsv[8]; load_rstd8(part, row0, fq, fq * 16 + fr, rsv);
#pragma unroll
        for (int ai = 0; ai < 2; ++ai)
#pragma unroll
            for (int m = 0; m < 4; ++m) {
                const int r = row0 + ai * HALF + m * 16; const float rs = rsv[ai * 4 + m];
                float sm = 0.f, sq = 0.f;
#pragma unroll
                for (int bj = 0; bj < 2; ++bj) {
                    float v[8];
#pragma unroll
                    for (int n = 0; n < 2; ++n)
#pragma unroll
                        for (int j = 0; j < 4; j += 2) {
                            f32x2 x = (f32x2){acc[ai][bj][m][n][j], acc[ai][bj][m][n][j + 1]} * rs;
                            if (act == 1) x = x * sigmoid_pk(x); else if (act == 2) x = gelu_pk(x); else if (act == 3) x = x * 0.0625f;
                            v[n * 4 + j] = x.x; v[n * 4 + j + 1] = x.y; sm += x.x + x.y; sq += x.x * x.x + x.y * x.y;
                        }
                    u32x4 w; w.x = pk2(v[0], v[1]); w.y = pk2(v[2], v[3]); w.z = pk2(v[4], v[5]); w.w = pk2(v[6], v[7]);
                    __builtin_nontemporal_store(w, (u32x4*)(Z + (size_t)r * ZW + col0 + bj * HALF));
                }
                if (dostat) {
                    sm += shx(sm, 16, (fq * 16 + fr)); sm += shx(sm, 32, (fq * 16 + fr)); sq += shx(sq, 16, (fq * 16 + fr)); sq += shx(sq, 32, (fq * 16 + fr));
                    if (fq == 0) *(f32x2*)(stat + (size_t)r * 64 + ((u.pn - 12) * 4 + wc) * 2) = (f32x2){sm, sq};
                }
            }
    }
};

struct EpiPlain {
    static constexpr bool PERM = true, AFTER_DRAIN = false;
    bf16_t* O; int ldo;
    __device__ __forceinline__ void operator()(const f32x4 (&acc)[2][2][4][2], const Unit& u, int wr, int wc, int fr, int fq) const {
        const int row0 = u.pm * BM + wr * 64 + fr, col0 = u.pn * BM + wc * 32 + 8 * fq;
#pragma unroll
        for (int ai = 0; ai < 2; ++ai)
#pragma unroll
            for (int m = 0; m < 4; ++m)
#pragma unroll
                for (int bj = 0; bj < 2; ++bj) {
                    const f32x4 a = acc[ai][bj][m][0], b = acc[ai][bj][m][1];
                    u32x4 w; w.x = pk2(a[0], a[1]); w.y = pk2(a[2], a[3]); w.z = pk2(b[0], b[1]); w.w = pk2(b[2], b[3]);
                    *(u32x4*)(O + (size_t)(row0 + ai * HALF + m * 16) * ldo + col0 + bj * HALF) = w;
                }
    }
};

struct EpiSoftmax {
    static constexpr bool PERM = true, AFTER_DRAIN = true;
    bf16_t* O; int ldo;
    __device__ __forceinline__ void fused(f32x4 (&acc)[2][2][4][2], const Unit&, int wr, int wc, int fr, int fq, LAS unsigned char* lds, int wid, int lane) const {
        LAS float* R1 = (LAS float*)lds;
        LAS float* R2 = (LAS float*)(lds + 4096);
#pragma unroll
        for (int ai = 0; ai < 2; ++ai)
#pragma unroll
            for (int m = 0; m < 4; ++m) {
                float mx = -3.0e38f;
#pragma unroll
                for (int bj = 0; bj < 2; ++bj)
#pragma unroll
                    for (int n = 0; n < 2; ++n)
#pragma unroll
                        for (int j = 0; j < 4; ++j) mx = fmaxf(mx, acc[ai][bj][m][n][j]);
                mx = fmaxf(mx, shx(mx, 16, (fq * 16 + fr))); mx = fmaxf(mx, shx(mx, 32, (fq * 16 + fr)));
                if (fq == 0) R1[wc * 256 + ai * HALF + wr * 64 + m * 16 + fr] = mx;
            }
        LDS_WAIT(); __builtin_amdgcn_s_barrier(); asm volatile("" ::: "memory");
#pragma unroll
        for (int ai = 0; ai < 2; ++ai)
#pragma unroll
            for (int m = 0; m < 4; ++m) {
                const int rl = ai * HALF + wr * 64 + m * 16 + fr;
                const float mx = fmaxf(fmaxf(R1[rl], R1[256 + rl]), fmaxf(R1[512 + rl], R1[768 + rl]));
                float sm = 0.f;
#pragma unroll
                for (int bj = 0; bj < 2; ++bj)
#pragma unroll
                    for (int n = 0; n < 2; ++n)
#pragma unroll
                        for (int j = 0; j < 4; ++j) { const float p = __expf(acc[ai][bj][m][n][j] - mx); acc[ai][bj][m][n][j] = p; sm += p; }
                sm += shx(sm, 16, (fq * 16 + fr)); sm += shx(sm, 32, (fq * 16 + fr));
                if (fq == 0) R2[wc * 256 + rl] = sm;
            }
        LDS_WAIT(); __builtin_amdgcn_s_barrier(); asm volatile("" ::: "memory");
        const int row0 = wr * 64 + fr, col0 = wc * 32 + 8 * fq;
#pragma unroll
        for (int ai = 0; ai < 2; ++ai)
#pragma unroll
            for (int m = 0; m < 4; ++m) {
                const int rl = ai * HALF + wr * 64 + m * 16 + fr;
                const float inv = 1.0f / ((R2[rl] + R2[256 + rl]) + (R2[512 + rl] + R2[768 + rl]));
#pragma unroll
                for (int bj = 0; bj < 2; ++bj) {
                    const f32x4 a = acc[ai][bj][m][0] * inv, b = acc[ai][bj][m][1] * inv;
                    u32x4 w; w.x = pk2(a[0], a[1]); w.y = pk2(a[2], a[3]); w.z = pk2(b[0], b[1]); w.w = pk2(b[2], b[3]);
                    *(u32x4*)(O + (size_t)(row0 + ai * HALF + m * 16) * ldo + col0 + bj * HALF) = w;
                }
            }
        LDS_WAIT(); __builtin_amdgcn_s_barrier(); asm volatile("" ::: "memory");
    }
};
}

__device__ __forceinline__ int map_row(int kind, int n) {
    if (kind == 1) { const int half = n >= FF ? 1 : 0; const int i = n - half * FF; return (i >> 7) * 256 + half * 128 + (i & 127); }
    if (kind == 2) { const int s = n >> 10; const int ds = (s == 0) ? 0 : (s == 4 ? 1 : s + 1); return ds * 1024 + (n & 1023); }
    if (kind == 3) { return n < 2048 ? n : (n < 4096 ? n + 1024 : n - 2048); }
    return n;
}
__device__ __forceinline__ void transpose_mat(LAS unsigned char* lds, const float* W, const float* gain, bf16_t* WT, int K, int N, int kind, int gw, int ngw, int wid, int lane) {
    LAS float* scr = (LAS float*)(lds + wid * 16384);
    const int nblk = N / 32, items = (K / 64) * nblk;
    if (gw >= items) return;
    float wv[32];
    {
        const int kb = gw / nblk, nb = gw - kb * nblk;
#pragma unroll
        for (int i = 0; i < 32; ++i) wv[i] = W[(size_t)(kb * 64 + 2 * i + (lane >> 5)) * N + nb * 32 + (lane & 31)];
    }
    for (int it = gw; it < items; it += ngw) {
        const int kb = it / nblk, nb = it - kb * nblk, k0 = kb * 64, n0 = nb * 32;
        const int c = lane & 7;
        f32x4 ga = (f32x4){1.f, 1.f, 1.f, 1.f}, gb = ga;
        if (gain) { ga = *(const f32x4*)(gain + k0 + 8 * c); gb = *(const f32x4*)(gain + k0 + 8 * c + 4); }
#pragma unroll
        for (int i = 0; i < 32; ++i) scr[(2 * i + (lane >> 5)) * 33 + (lane & 31)] = wv[i];
        const int nx = it + ngw;
        if (nx < items) {
            const int kb2 = nx / nblk, nb2 = nx - kb2 * nblk;
#pragma unroll
            for (int i = 0; i < 32; ++i) wv[i] = W[(size_t)(kb2 * 64 + 2 * i + (lane >> 5)) * N + nb2 * 32 + (lane & 31)];
        }
        LDS_WAIT(); asm volatile("" ::: "memory");
        const int drow0 = map_row(kind, n0);
#pragma unroll
        for (int j = 0; j < 4; ++j) { const int n = (lane >> 3) + 8 * j; const LAS float* sp = scr + (8 * c) * 33 + n;
            u32x4 o; o.x = pk2(sp[0 * 33] * ga[0], sp[1 * 33] * ga[1]); o.y = pk2(sp[2 * 33] * ga[2], sp[3 * 33] * ga[3]); o.z = pk2(sp[4 * 33] * gb[0], sp[5 * 33] * gb[1]); o.w = pk2(sp[6 * 33] * gb[2], sp[7 * 33] * gb[3]);
            *(u32x4*)(WT + (size_t)(drow0 + n) * K + k0 + 8 * c) = o; }
        LDS_WAIT(); asm volatile("" ::: "memory");
    }
}

__device__ __forceinline__ void hgrn_item(LAS unsigned char* lds, bf16_t* Z, const float* lb_logits, const float* gnorm, int b, int h, int wid0) {
    const int wid = opaque_s(wid0), lane = lane_id(), tid = wid * 64 + lane, fr = lane & 15, fq = lane >> 4;
    lds += opaque_s(0);
    constexpr int QD_OFF = 0, RS272 = 272, KI_OFF = 17408, KDT_OFF = 34816, RS144 = 144, VT_OFF = 53248, A1_OFF = 71680, ST_OFF = 80896, MISC_OFF = 115712;
    LAS float* tot = (LAS float*)(lds + MISC_OFF);
    LAS float* bl = (LAS float*)(lds + MISC_OFF + 4096);
    LAS float* lbv = (LAS float*)(lds + MISC_OFF + 4608);
    LAS float* gnv = (LAS float*)(lds + MISC_OFF + 5120);
    LAS float* ssqp = (LAS float*)(lds + MISC_OFF + 5632);
    for (int i = tid; i < 34816 / 4; i += NTHREADS) ((LAS unsigned*)(lds + ST_OFF))[i] = 0u;
    if (tid < 128) {
        const int ch = h * 128 + tid;
        const float l0 = lb_logits[ch], l1 = lb_logits[1024 + ch], l2 = lb_logits[2048 + ch];
        const float mx = fmaxf(l0, fmaxf(l1, l2));
        const float e0 = __expf(l0 - mx), e1 = __expf(l1 - mx), e2 = __expf(l2 - mx);
        lbv[tid] = e0 / (e0 + e1 + e2);
        gnv[tid] = gnorm[tid];
    }
    f32x4 S[8];
#pragma unroll
    for (int i = 0; i < 8; ++i) S[i] = (f32x4){0.f, 0.f, 0.f, 0.f};
    LDS_WAIT(); __syncthreads();
    const int t0 = wid * 8;
    const f32x2 lb2 = *(const LAS f32x2*)(lbv + 2 * lane);
    const float oml0 = 1.0f - lb2[0], oml1 = 1.0f - lb2[1];
    const bf16_t* zbase = Z + ((size_t)b * T + t0) * ZW + h * 128 + 2 * lane;
    unsigned zfr[8], qr[8], vr[8];
#pragma unroll
    for (int i = 0; i < 8; ++i) { zfr[i] = *(const unsigned*)(zbase + (size_t)i * ZW + 2048); qr[i] = *(const unsigned*)(zbase + (size_t)i * ZW); vr[i] = *(const unsigned*)(zbase + (size_t)i * ZW + 3072); }
    const int tt2 = wid & 3, vh = wid >> 2;
    for (int n = 0; n < T / 64; ++n) {
        const size_t row0 = (size_t)b * T + (size_t)n * 64;
        bf16_t* orow = Z + (row0 + tt2 * 16 + fr) * ZW + h * 128;
        u32x2 gg[4];
#pragma unroll
        for (int i = 0; i < 4; ++i) gg[i] = *(const u32x2*)(orow + 4096 + (vh * 4 + i) * 16 + fq * 4);
        f32x2 lp[8], kk[8]; f32x2 cp = (f32x2){1.f, 1.f};
        const f32x2 oml2 = (f32x2){oml0, oml1};
#pragma unroll
        for (int i = 0; i < 8; ++i) {
            const f32x2 z = __builtin_elementwise_max((f32x2){bflo(zfr[i]), bfhi(zfr[i])}, (f32x2){-30.f, -30.f});
            const f32x2 t = z * (-1.4426950408889634f);
            f32x2 e; e.x = __builtin_amdgcn_exp2f(t.x); e.y = __builtin_amdgcn_exp2f(t.y);
            const f32x2 d = e + 1.0f;
            const float r = fast_rcp(d.x * d.y);
            const f32x2 sg = (f32x2){r * d.y, r * d.x};
            const f32x2 f = lb2 + oml2 * sg;
            kk[i] = oml2 * (e * sg);
            cp = cp * f; lp[i] = cp;
        }
        *(LAS f32x2*)(tot + wid * 128 + 2 * lane) = cp;
        WG_BAR();
        {
            f32x2 off = (f32x2){1.f, 1.f}, blp = (f32x2){1.f, 1.f};
#pragma unroll
            for (int j = 0; j < 8; ++j) { const f32x2 t2 = *(const LAS f32x2*)(tot + j * 128 + 2 * lane); if (j < wid) off = off * t2; blp = blp * t2; }
            float kd0[8], kd1[8];
#pragma unroll
            for (int i = 0; i < 8; ++i) {
                const f32x2 e = off * lp[i];
                f32x2 iv; iv.x = fast_rcp(e.x); iv.y = fast_rcp(e.y);
                const f32x2 q = (f32x2){bflo(qr[i]), bfhi(qr[i])} * e;
                const f32x2 ki = kk[i] * iv;
                const f32x2 kd = kk[i] * (blp * iv);
                *(LAS unsigned*)(lds + QD_OFF + (t0 + i) * RS272 + lane * 4) = pk2(q.x, q.y);
                *(LAS unsigned*)(lds + KI_OFF + (t0 + i) * RS272 + lane * 4) = pk2(ki.x, ki.y);
                kd0[i] = kd.x; kd1[i] = kd.y;
            }
            *(LAS u32x4*)(lds + KDT_OFF + (2 * lane) * RS144 + t0 * 2) = (u32x4){pk2(kd0[0], kd0[1]), pk2(kd0[2], kd0[3]), pk2(kd0[4], kd0[5]), pk2(kd0[6], kd0[7])};
            *(LAS u32x4*)(lds + KDT_OFF + (2 * lane + 1) * RS144 + t0 * 2) = (u32x4){pk2(kd1[0], kd1[1]), pk2(kd1[2], kd1[3]), pk2(kd1[4], kd1[5]), pk2(kd1[6], kd1[7])};
            *(LAS u32x4*)(lds + VT_OFF + (2 * lane) * RS144 + t0 * 2) = (u32x4){(vr[0] & 0xffffu) | (vr[1] << 16), (vr[2] & 0xffffu) | (vr[3] << 16), (vr[4] & 0xffffu) | (vr[5] << 16), (vr[6] & 0xffffu) | (vr[7] << 16)};
            *(LAS u32x4*)(lds + VT_OFF + (2 * lane + 1) * RS144 + t0 * 2) = (u32x4){(vr[0] >> 16) | (vr[1] & 0xffff0000u), (vr[2] >> 16) | (vr[3] & 0xffff0000u), (vr[4] >> 16) | (vr[5] & 0xffff0000u), (vr[6] >> 16) | (vr[7] & 0xffff0000u)};
            if (wid == 0) *(LAS f32x2*)(bl + 2 * lane) = blp;
        }
        if (n + 1 < T / 64) {
            zbase += (size_t)64 * ZW;
#pragma unroll
            for (int i = 0; i < 8; ++i) { zfr[i] = *(const unsigned*)(zbase + (size_t)i * ZW + 2048); qr[i] = *(const unsigned*)(zbase + (size_t)i * ZW); vr[i] = *(const unsigned*)(zbase + (size_t)i * ZW + 3072); }
        }
        WG_BAR();
        {
            const int tt = wid >> 1;
            bf16x8 Yq[4];
#pragma unroll
            for (int ks = 0; ks < 4; ++ks) Yq[ks] = *(const LAS bf16x8*)(lds + QD_OFF + (tt * 16 + fr) * RS272 + (ks * 32 + fq * 8) * 2);
#pragma unroll
            for (int si = 0; si < 2; ++si) {
                const int st = (wid & 1) * 2 + si;
                f32x4 a = (f32x4){0.f, 0.f, 0.f, 0.f};
                if (st <= tt) {
#pragma unroll
                    for (int ks = 0; ks < 4; ++ks) {
                        const bf16x8 X = *(const LAS bf16x8*)(lds + KI_OFF + (st * 16 + fr) * RS272 + (ks * 32 + fq * 8) * 2);
                        a = mfma16(X, Yq[ks], a);
                    }
                }
                const int t = tt * 16 + fr, s0 = st * 16 + fq * 4;
                float v[4];
#pragma unroll
                for (int j = 0; j < 4; ++j) v[j] = (s0 + j <= t) ? a[j] : 0.f;
                *(LAS u32x2*)(lds + A1_OFF + t * RS144 + s0 * 2) = (u32x2){pk2(v[0], v[1]), pk2(v[2], v[3])};
            }
        }
        WG_BAR();
        {
            const int tt = tt2;
            f32x4 o[4];
            float ss = 0.f;
            bf16x8 Ya[2], Yq[4];
#pragma unroll
            for (int ks = 0; ks < 2; ++ks) Ya[ks] = *(const LAS bf16x8*)(lds + A1_OFF + (tt * 16 + fr) * RS144 + (ks * 32 + fq * 8) * 2);
#pragma unroll
            for (int ks = 0; ks < 4; ++ks) Yq[ks] = *(const LAS bf16x8*)(lds + QD_OFF + (tt * 16 + fr) * RS272 + (ks * 32 + fq * 8) * 2);
#pragma unroll
            for (int i = 0; i < 4; ++i) {
                const int vt = vh * 4 + i;
                f32x4 a = (f32x4){0.f, 0.f, 0.f, 0.f};
#pragma unroll
                for (int ks = 0; ks < 2; ++ks) {
                    const bf16x8 X = *(const LAS bf16x8*)(lds + VT_OFF + (vt * 16 + fr) * RS144 + (ks * 32 + fq * 8) * 2);
                    a = mfma16(X, Ya[ks], a);
                }
#pragma unroll
                for (int ks = 0; ks < 4; ++ks) {
                    const bf16x8 X = *(const LAS bf16x8*)(lds + ST_OFF + (vt * 16 + fr) * RS272 + (ks * 32 + fq * 8) * 2);
                    a = mfma16(X, Yq[ks], a);
                }
                o[i] = a;
                ss += (a[0] * a[0] + a[1] * a[1]) + (a[2] * a[2] + a[3] * a[3]);
            }
            ss += shx(ss, 16, lane); ss += shx(ss, 32, lane);
            if (fq == 0) ssqp[vh * 64 + tt * 16 + fr] = ss;
            WG_BAR();
            const float tss = ssqp[tt * 16 + fr] + ssqp[64 + tt * 16 + fr];
            const float rs = __builtin_amdgcn_rsqf(tss * (1.0f / 128.0f) + EPS);
#pragma unroll
            for (int i = 0; i < 4; ++i) {
                const int v0 = (vh * 4 + i) * 16 + fq * 4;
                const f32x4 gn = *(const LAS f32x4*)(gnv + v0);
                const float r0 = o[i][0] * rs * gn[0] * bflo(gg[i].x), r1 = o[i][1] * rs * gn[1] * bfhi(gg[i].x);
                const float r2 = o[i][2] * rs * gn[2] * bflo(gg[i].y), r3 = o[i][3] * rs * gn[3] * bfhi(gg[i].y);
                __builtin_nontemporal_store((u32x2){pk2(r0, r1), pk2(r2, r3)}, (u32x2*)(orow + v0));
            }
        }
        {
            const f32x4 dec = *(const LAS f32x4*)(bl + wid * 16 + fq * 4);
            bf16x8 X[2];
#pragma unroll
            for (int ks = 0; ks < 2; ++ks) X[ks] = *(const LAS bf16x8*)(lds + KDT_OFF + (wid * 16 + fr) * RS144 + (ks * 32 + fq * 8) * 2);
#pragma unroll
            for (int vt = 0; vt < 8; ++vt) {
                f32x4 a = S[vt] * dec;
#pragma unroll
                for (int ks = 0; ks < 2; ++ks) {
                    const bf16x8 Y = *(const LAS bf16x8*)(lds + VT_OFF + (vt * 16 + fr) * RS144 + (ks * 32 + fq * 8) * 2);
                    a = mfma16(X[ks], Y, a);
                }
                S[vt] = a;
                *(LAS u32x2*)(lds + ST_OFF + (vt * 16 + fr) * RS272 + (wid * 16 + fq * 4) * 2) = (u32x2){pk2(a[0], a[1]), pk2(a[2], a[3])};
            }
        }
    }
    LDS_WAIT(); __syncthreads();
}

__device__ __forceinline__ void attn_unit(LAS unsigned char* lds, bf16_t* Zx  , const bf16_t* Kb, const bf16_t* Vt, int item, int wid0) {
    const int qt = item & 7, h = (item >> 3) & 3, b = item >> 5;
    bf16_t* q = Zx + ((size_t)b * T + (size_t)qt * 256) * ZW + h * 256;
    pg8::OneUnit S; S.u.pm = 0; S.u.pn = 0;
    {
        pg8::Gemm g{q, Kb + (size_t)b * 256 * 2048 + h * 256, ZW, 2048, 256};
        pg8::EpiSoftmax E{q, ZW};
        pg8::gemm_phase<pg8::EpiSoftmax, pg8::OneUnit, false>(lds, g, S, E, wid0);
    }
    asm volatile("s_waitcnt vmcnt(0)" ::: "memory"); __builtin_amdgcn_s_barrier(); asm volatile("" ::: "memory");
    if (opaque_s(wid0) == 0) { __builtin_amdgcn_fence(__ATOMIC_ACQUIRE, "agent"); asm volatile("s_waitcnt vmcnt(0)" ::: "memory"); }
    asm volatile("" ::: "memory"); __builtin_amdgcn_s_barrier(); asm volatile("" ::: "memory");
    {
        pg8::Gemm g{q, Vt + (size_t)((b * 4 + h) * 256) * 256, ZW, 256, 256};
        pg8::EpiPlain E{q, ZW};
        pg8::gemm_phase<pg8::EpiPlain, pg8::OneUnit, false>(lds, g, S, E, wid0);
    }
    asm volatile("" ::: "memory"); __builtin_amdgcn_s_barrier(); asm volatile("" ::: "memory");
}

#define GMLP_LOAD(IT_) do { const int g_ = (IT_) & 7; const size_t r0_ = (size_t)((IT_) >> 7) * T + (size_t)(((IT_) >> 3) & 15) * 128; \
        _Pragma("unroll") for (int q = 0; q < 4; ++q) sp[q] = *(const f32x4*)(stat + (r0_ + stok) * 64 + (sq4 * 4 + q) * 4); \
        _Pragma("unroll") for (int it2 = 0; it2 < 2; ++it2) _Pragma("unroll") for (int j = 0; j < 4; ++j) \
            w[it2][j] = *(const u32x4*)(Z + (r0_ + (tg0 + 16 * it2) * 4 + j) * ZW + 3072 + g_ * 256 + c0); } while (0)
__device__ __forceinline__ void gmlp_items(LAS unsigned char* lds0, bf16_t* Z, const float* stat, const float* ln_g, const float* ln_b, const bf16_t* Wm, const float* bs, int item0, int istep, int nitems, int wid0) {
    constexpr int VTS = 272;
    f32x4 sp[4]; u32x4 w[2][4];
    constexpr int WL_OFF = 70656, WLS = 272;
    {
        const int wid = opaque_s(wid0), lane = lane_id(), tid = wid * 64 + lane;
        const int tg0 = tid >> 5, c0 = (tid & 31) * 8, stok = tid >> 2, sq4 = tid & 3;
        const bf16_t* wgp = Wm + (size_t)(item0 & 7) * 128 * 128;
        u32x4 wm[4];
#pragma unroll
        for (int q = 0; q < 4; ++q) wm[q] = *(const u32x4*)(wgp + (size_t)(tid + q * NTHREADS) * 8);
#pragma unroll
        for (int q = 0; q < 4; ++q) { const int idx = tid + q * NTHREADS; *(LAS u32x4*)(lds0 + WL_OFF + (idx >> 4) * WLS + (idx & 15) * 16) = wm[q]; }
        GMLP_LOAD(item0);
    }
    for (int k = 0; k < nitems; ++k) {
        const int wid = opaque_s(wid0), lane = lane_id(), tid = wid * 64 + lane, fr = lane & 15, fq = lane >> 4;
        LAS unsigned char* lds = lds0 + opaque_s(0);
        LAS float* murs = (LAS float*)(lds + 69632);
        const int cg8 = tid & 31, tg0 = tid >> 5, c0 = cg8 * 8, stok = tid >> 2, sq4 = tid & 3;
        const int item = item0 + k * istep;
        const int g = item & 7, n = (item >> 3) & 15, b = item >> 7;
        const size_t row0 = (size_t)b * T + (size_t)n * 128;
        {
            float sm = 0.f, sq = 0.f;
#pragma unroll
            for (int q = 0; q < 4; ++q) { sm += sp[q][0] + sp[q][2]; sq += sp[q][1] + sp[q][3]; }
            sm += shx(sm, 1, lane); sm += shx(sm, 2, lane); sq += shx(sq, 1, lane); sq += shx(sq, 2, lane);
            const float mean = sm * (1.0f / 2048.0f);
            const float var = fmaxf(sq * (1.0f / 2048.0f) - mean * mean, 0.f);
            if (sq4 == 0) *(LAS f32x2*)(murs + stok * 2) = (f32x2){mean, __builtin_amdgcn_rsqf(var + EPS)};
        }
        WG_BAR();
        {
            const f32x4 g0 = *(const f32x4*)(ln_g + g * 256 + c0), g1 = *(const f32x4*)(ln_g + g * 256 + c0 + 4);
            const f32x4 b0 = *(const f32x4*)(ln_b + g * 256 + c0), b1 = *(const f32x4*)(ln_b + g * 256 + c0 + 4);
#pragma unroll
            for (int it2 = 0; it2 < 2; ++it2) {
                const int t0 = (tg0 + 16 * it2) * 4;
                float nv[4][8];
#pragma unroll
                for (int j = 0; j < 4; ++j) {
                    const f32x2 mr = *(const LAS f32x2*)(murs + (t0 + j) * 2);
                    const float mu = mr[0], rs = mr[1];
                    const u32x4 x = w[it2][j];
                    nv[j][0] = (bflo(x.x) - mu) * rs * g0[0] + b0[0]; nv[j][1] = (bfhi(x.x) - mu) * rs * g0[1] + b0[1];
                    nv[j][2] = (bflo(x.y) - mu) * rs * g0[2] + b0[2]; nv[j][3] = (bfhi(x.y) - mu) * rs * g0[3] + b0[3];
                    nv[j][4] = (bflo(x.z) - mu) * rs * g1[0] + b1[0]; nv[j][5] = (bfhi(x.z) - mu) * rs * g1[1] + b1[1];
                    nv[j][6] = (bflo(x.w) - mu) * rs * g1[2] + b1[2]; nv[j][7] = (bfhi(x.w) - mu) * rs * g1[3] + b1[3];
                }
                const int qp = ((t0 >> 3) ^ (cg8 & 15)) * 16 + ((t0 >> 2) & 1) * 8;
#pragma unroll
                for (int e = 0; e < 8; ++e)
                    *(LAS u32x2*)(lds + (c0 + e) * VTS + qp) = (u32x2){pk2(nv[0][e], nv[1][e]), pk2(nv[2][e], nv[3][e])};
            }
        }
        const int th = wid & 1, ch = wid >> 1;
        u32x2 uu[4][4];
#pragma unroll
        for (int a = 0; a < 4; ++a)
#pragma unroll
            for (int c = 0; c < 4; ++c) uu[a][c] = *(const u32x2*)(Z + (row0 + th * 64 + a * 16 + fr) * ZW + g * 256 + ch * 64 + fq * 4 + c * 16);
        float biasv[4];
#pragma unroll
        for (int a = 0; a < 4; ++a) biasv[a] = bs[g * 128 + th * 64 + a * 16 + fr];
        if (k + 1 < nitems) GMLP_LOAD(item + istep);
        WG_BAR();
        f32x4 acc[4][4];
#pragma unroll
        for (int a = 0; a < 4; ++a)
#pragma unroll
            for (int c = 0; c < 4; ++c) acc[a][c] = (f32x4){0.f, 0.f, 0.f, 0.f};
#pragma unroll
        for (int ks = 0; ks < 4; ++ks) {
            if (32 * ks <= th * 64 + 63) {
                bf16x8 X[4];
#pragma unroll
                for (int c = 0; c < 4; ++c) { const int crow = ch * 64 + c * 16 + fr; X[c] = *(const LAS bf16x8*)(lds + crow * VTS + (((ks * 4 + fq) ^ ((crow >> 3) & 15)) * 16)); }
#pragma unroll
                for (int a = 0; a < 4; ++a) {
                    const int tgl = th * 64 + a * 16;
                    if (32 * ks <= tgl + 15) {
                        const bf16x8 Y = *(const LAS bf16x8*)(lds + WL_OFF + (tgl + fr) * WLS + (ks * 32 + fq * 8) * 2);
#pragma unroll
                        for (int c = 0; c < 4; ++c) acc[a][c] = mfma16(X[c], Y, acc[a][c]);
                    }
                }
            }
        }
#pragma unroll
        for (int a = 0; a < 4; ++a) {
            const int t = th * 64 + a * 16 + fr;
            const float bias = biasv[a];
            bf16_t* ur = Z + (row0 + t) * ZW + g * 256 + ch * 64 + fq * 4;
#pragma unroll
            for (int c = 0; c < 4; ++c) {
                const float r0 = (acc[a][c][0] + bias) * bflo(uu[a][c].x), r1 = (acc[a][c][1] + bias) * bfhi(uu[a][c].x);
                const float r2 = (acc[a][c][2] + bias) * bflo(uu[a][c].y), r3 = (acc[a][c][3] + bias) * bfhi(uu[a][c].y);
                __builtin_nontemporal_store((u32x2){pk2(r0, r1), pk2(r2, r3)}, (u32x2*)(ur + c * 16));
            }
        }
        WG_BAR();
    }
}
#undef GMLP_LOAD

struct Args { const float* in[22]; float* out; unsigned char* ws; };

__device__ __forceinline__ void grid_bar(unsigned* cnt, unsigned target, int wid, int lane) {
    asm volatile("s_waitcnt vmcnt(0) lgkmcnt(0)" ::: "memory");
    __builtin_amdgcn_s_barrier();
    if (wid == 0 && lane == 0) {
        __builtin_amdgcn_fence(__ATOMIC_RELEASE, "agent");
        asm volatile("s_waitcnt vmcnt(0)" ::: "memory");
        __hip_atomic_fetch_add(cnt, 1u, __ATOMIC_RELAXED, __HIP_MEMORY_SCOPE_AGENT);
        while (__hip_atomic_load(cnt, __ATOMIC_RELAXED, __HIP_MEMORY_SCOPE_AGENT) < target) __builtin_amdgcn_s_sleep(16);
        __builtin_amdgcn_fence(__ATOMIC_ACQUIRE, "agent");
        asm volatile("s_waitcnt vmcnt(0)" ::: "memory");
    }
    asm volatile("" ::: "memory");
    __builtin_amdgcn_s_barrier();
    asm volatile("" ::: "memory");
}

__device__ __forceinline__ void convert_phase(LAS unsigned char* lds, const Args& a, unsigned char* ws, int L, int G, int bx, int wid0, int mask, bool inputs) {
    const int wid = opaque_s(wid0), lane = lane_id(), tid = wid * 64 + lane;
    const int gw = bx * 8 + wid, ngw = G * 8;
    for (int mi = 0; mi < 7; ++mi) {
        if (!((mask >> mi) & 1)) continue;
        const float* W; const float* gain = nullptr; bf16_t* WT; int K, N, kind = 0;
        if (mi == 0) { W = a.in[5] + (size_t)L * D * 2 * FF; gain = a.in[4] + L * D; WT = (bf16_t*)(ws + WS_W1IN); K = D; N = 2 * FF; kind = 1; }
        else if (mi == 1) { W = a.in[6] + (size_t)L * FF * D; WT = (bf16_t*)(ws + WS_W1OUT); K = FF; N = D; }
        else if (mi == 2) { W = a.in[19] + (size_t)L * D * 2 * FF; gain = a.in[18] + L * D; WT = (bf16_t*)(ws + (L == 0 ? WS_W2IN : WS_W2IN1)); K = D; N = 2 * FF; kind = 1; }
        else if (mi == 3) { W = a.in[20] + (size_t)L * FF * D; WT = (bf16_t*)(ws + (L == 0 ? WS_W2OUT : WS_W2OUT1)); K = FF; N = D; }
        else if (mi == 4) { W = a.in[8] + (size_t)L * D * 2048; WT = (bf16_t*)(ws + WS_WKV); K = D; N = 2048; }
        else if (mi == 5) { W = (L == 0) ? a.in[9] : a.in[12]; gain = a.in[7] + L * D; WT = (bf16_t*)(ws + WS_WIN); K = D; N = ZW; kind = (L == 0) ? 2 : 3; }
        else { W = (L == 0) ? a.in[11] : a.in[17]; WT = (bf16_t*)(ws + (L == 0 ? WS_WOUT : WS_WOUT1)); K = (L == 0) ? 2048 : 3072; N = D; }
        transpose_mat(lds, W, gain, WT, K, N, kind, gw, ngw, wid, lane);
    }
    if (inputs) {
        float* part = (float*)(ws + WS_PART); bf16_t* xb = (bf16_t*)(ws + WS_XB);
        bf16_t* Wm = (bf16_t*)(ws + WS_WM); bf16_t* memn = (bf16_t*)(ws + WS_MEMN);
        {
            f32x4 v[4][4];
            int r4 = gw * 4;
            if (r4 < M) {
#pragma unroll
                for (int q = 0; q < 4; ++q)
#pragma unroll
                    for (int j = 0; j < 4; ++j) v[q][j] = *((const f32x4*)(a.in[0] + (size_t)(r4 + q) * D) + 64 * j + lane);
            }
            for (; r4 < M; r4 += ngw * 4) {
                f32x4 w[4][4];
#pragma unroll
                for (int q = 0; q < 4; ++q)
#pragma unroll
                    for (int j = 0; j < 4; ++j) w[q][j] = v[q][j];
                const int rn = r4 + ngw * 4;
                if (rn < M) {
#pragma unroll
                    for (int q = 0; q < 4; ++q)
#pragma unroll
                        for (int j = 0; j < 4; ++j) v[q][j] = *((const f32x4*)(a.in[0] + (size_t)(rn + q) * D) + 64 * j + lane);
                }
#pragma unroll
                for (int q = 0; q < 4; ++q) {
                    float ss = 0.f;
#pragma unroll
                    for (int j = 0; j < 4; ++j) { const f32x4 x = w[q][j]; ss += (x[0] * x[0] + x[1] * x[1]) + (x[2] * x[2] + x[3] * x[3]);
                        *((u32x2*)(xb + (size_t)(r4 + q) * D) + 64 * j + lane) = (u32x2){pk2(x[0], x[1]), pk2(x[2], x[3])}; }
                    ss = wave_sum(ss, lane);
                    if (lane < 16) part[(size_t)(r4 + q) * 16 + lane] = (lane == 0) ? ss : 0.f;
                }
            }
        }
        for (int r = gw; r < MROWS; r += ngw) {
            const f32x4* xr = (const f32x4*)(a.in[1] + (size_t)r * D) + lane;
            const f32x4* gr = (const f32x4*)(a.in[2]) + lane;
            f32x4 v[4]; float ss = 0.f;
#pragma unroll
            for (int j = 0; j < 4; ++j) { v[j] = xr[64 * j]; ss += (v[j][0] * v[j][0] + v[j][1] * v[j][1]) + (v[j][2] * v[j][2] + v[j][3] * v[j][3]); }
            ss = wave_sum(ss, lane);
            const float rs = 1.0f / sqrtf(ss * (1.0f / 1024.0f) + EPS);
#pragma unroll
            for (int j = 0; j < 4; ++j) { const f32x4 gg = gr[64 * j];
                *((u32x2*)(memn + (size_t)r * D) + 64 * j + lane) = (u32x2){pk2(v[j][0] * rs * gg[0], v[j][1] * rs * gg[1]), pk2(v[j][2] * rs * gg[2], v[j][3] * rs * gg[3])}; }
        }
        for (int i = bx * NTHREADS + tid; i < 8 * 128 * 128; i += G * NTHREADS) {
            const int s = i & 127, t = (i >> 7) & 127;
            Wm[i] = (s <= t) ? (bf16_t)(pk2(a.in[15][i], 0.f) & 0xffffu) : (bf16_t)0;
        }
    }
}

__global__ void __launch_bounds__(NTHREADS, 2) mega_fwd(Args a) {
    extern __shared__ __attribute__((aligned(16))) unsigned char lds_raw[];
    LAS unsigned char* lds = (LAS unsigned char*)lds_raw;
    const int G = gridDim.x, bx = blockIdx.x;
    const int wid0 = __builtin_amdgcn_readfirstlane(threadIdx.x >> 6);
    unsigned* barcnt = (unsigned*)(a.ws + WS_CTL);

    cg::this_grid().sync();

    const int gx = bx & 7, gj = bx >> 3;
    unsigned* grpcnt = barcnt + 64 * (1 + gx);
    unsigned ng = 0, nl = 0;

    for (int ph = 0; ph < 16; ++ph) {
        if (ph == 8) continue;
        const int L = ph >> 3, k = ph & 7;
        unsigned char* ws = a.ws; asm volatile("" : "+s"(ws));
        float* part = (float*)(ws + WS_PART); float* stat = (float*)(ws + WS_STAT);
        bf16_t* xb = (bf16_t*)(ws + WS_XB); bf16_t* Z = (bf16_t*)(ws + WS_Z); bf16_t* HID = Z;
        bf16_t* Kb = (bf16_t*)(ws + WS_KB); bf16_t* Vt = (bf16_t*)(ws + WS_VT);
        if (k == 0) {
            convert_phase(lds, a, ws, 0, G, bx, wid0, 0x7f, true);
        } else if (k == 1 || k == 6) {
            {
                pg8::Gemm g{xb, (const bf16_t*)(ws + (k == 1 ? WS_W1IN : (L == 0 ? WS_W2IN : WS_W2IN1))), D, D, D}; pg8::StaticOrder S; S.init(M, 2 * FF, G, bx);
                pg8::EpiSwiglu E{HID, part};
                pg8::gemm_phase<pg8::EpiSwiglu, pg8::StaticOrder, true>(lds, g, S, E, wid0);
            }
            if (k == 1) {
                pg8::Gemm g{(const bf16_t*)(ws + WS_MEMN), (const bf16_t*)(ws + WS_WKV), D, D, D};
                pg8::FixedUnit S; S.has = (gj >= 16); S.u.pm = 2 * gx + ((gj >> 3) & 1); S.u.pn = gj & 7;
                pg8::EpiPlain E{Kb, 2048};
                pg8::gemm_phase<pg8::EpiPlain, pg8::FixedUnit, true>(lds, g, S, E, wid0);
            }
        } else if (k == 2 || k == 5 || k == 7) {
            const int Kc = (k == 5) ? ((L == 0) ? 2048 : 3072) : FF;
            const bf16_t* A = (k == 5) ? Z : HID; const int lda = ZW;
            const bf16_t* Bt = (const bf16_t*)(ws + (k == 2 ? WS_W1OUT : (k == 5 ? (L == 0 ? WS_WOUT : WS_WOUT1) : (L == 0 ? WS_W2OUT : WS_W2OUT1))));
            pg8::Gemm g{A, Bt, lda, Kc, Kc}; pg8::StaticOrder S; S.init(M, D, G, bx);
            pg8::EpiResid E{(ph == 2) ? a.in[0] : nullptr, xb, part, (k == 5) ? 1.0f : 0.5f};
            pg8::gemm_phase<pg8::EpiResid, pg8::StaticOrder, true>(lds, g, S, E, wid0);
            if (k == 2) {
                const int lane = lane_id(), tid = opaque_s(wid0) * 64 + lane;
                unsigned vv[4][8];
#pragma unroll
                for (int q = 0; q < 4; ++q) {
                    const int i = gj * NTHREADS + tid + q * 32 * NTHREADS;
                    const int d = i & 255, mc = (i >> 8) & 31, bh = 8 * gx + (i >> 13);
                    const bf16_t* src = Kb + (size_t)((bh >> 2) * 256 + mc * 8) * 2048 + 1024 + (bh & 3) * 256 + d;
#pragma unroll
                    for (int e = 0; e < 8; ++e) vv[q][e] = src[(size_t)e * 2048];
                }
#pragma unroll
                for (int q = 0; q < 4; ++q) {
                    const int i = gj * NTHREADS + tid + q * 32 * NTHREADS;
                    const int d = i & 255, mc = (i >> 8) & 31, bh = 8 * gx + (i >> 13);
                    *(u32x4*)(Vt + ((size_t)bh * 256 + d) * 256 + mc * 8) = (u32x4){vv[q][0] | (vv[q][1] << 16), vv[q][2] | (vv[q][3] << 16), vv[q][4] | (vv[q][5] << 16), vv[q][6] | (vv[q][7] << 16)};
                }
            }
        } else if (k == 3) {
            pg8::Gemm g{xb, (const bf16_t*)(ws + WS_WIN), D, D, D}; pg8::StaticOrder S; S.init(M, ZW, G, bx);
            pg8::EpiZ E{Z, part, stat, L};
            pg8::gemm_phase<pg8::EpiZ, pg8::StaticOrder, true>(lds, g, S, E, wid0);
        } else {
            bf16_t* Zx = Z + ((L == 0) ? 1024 : 2048);
            if (L == 0) {
                if (gj < 16) hgrn_item(lds, Z, a.in[3], a.in[10], 2 * gx + (gj >> 3), gj & 7, wid0);
                else {
                    for (int u = gj - 16; u < 64; u += 16) attn_unit(lds, Zx, Kb, Vt, (2 * gx + (u >> 5)) * 32 + (u & 31), wid0);
                    convert_phase(lds, a, ws, 1, 128, gx * 16 + (gj - 16), wid0, 0x7f, false);
                }
            } else {
                gmlp_items(lds, Z, stat, a.in[13], a.in[14], (const bf16_t*)(ws + WS_WM), a.in[16], (2 * gx) * 128 + gj, 32, 8, wid0);
                for (int u = gj; u < 64; u += 32) attn_unit(lds, Zx, Kb, Vt, (2 * gx + (u >> 5)) * 32 + (u & 31), wid0);
            }
        }
        if (ph == 0 || ph == 3 || ph == 7) { ++ng; grid_bar(barcnt, ng * (unsigned)G, opaque_s(wid0), lane_id()); }
        else { ++nl; grid_bar(grpcnt, nl * 32u, opaque_s(wid0), lane_id()); }
    }
    {
        const int wid = opaque_s(wid0), lane = lane_id();
        const float* part = (const float*)(a.ws + WS_PART); float* xres = a.out; const bf16_t* xbf = (const bf16_t*)(a.ws + WS_XB);
        const f32x4* gr = (const f32x4*)(a.in[21]) + lane;
        f32x4 gg[4];
#pragma unroll
        for (int j = 0; j < 4; ++j) gg[j] = gr[64 * j];
        for (int r0 = 4096 * gx + gj * 8 + wid; r0 < 4096 * (gx + 1); r0 += 1024) {
            f32x4 pp[4]; u32x2 xv[4][4];
#pragma unroll
            for (int q = 0; q < 4; ++q) {
                const int r = r0 + 256 * q;
                pp[q] = *((const f32x4*)(part + (size_t)r * 16) + (lane & 3));
#pragma unroll
                for (int j = 0; j < 4; ++j) xv[q][j] = *((const u32x2*)(xbf + (size_t)r * D) + lane + 64 * j);
            }
#pragma unroll
            for (int q = 0; q < 4; ++q) {
                const int r = r0 + 256 * q;
                float sm = (pp[q][0] + pp[q][1]) + (pp[q][2] + pp[q][3]);
                sm += shx(sm, 1, lane); sm += shx(sm, 2, lane);
                const float rs = __builtin_amdgcn_rsqf(sm * (1.0f / 1024.0f) + EPS);
                f32x4* xr = (f32x4*)(xres + (size_t)r * D) + lane;
#pragma unroll
                for (int j = 0; j < 4; ++j) { const u32x2 v = xv[q][j]; xr[64 * j] = (f32x4){bflo(v.x) * rs * gg[j][0], bfhi(v.x) * rs * gg[j][1], bflo(v.y) * rs * gg[j][2], bfhi(v.y) * rs * gg[j][3]}; }
            }
        }
    }
}

extern "C" void kernel_launch(void* const* d_in, const int* in_sizes, int n_in, void* d_out, int out_size, void* d_ws, size_t ws_size, hipStream_t stream) {
    static int grid = 0;
    if (grid == 0) {
        if (n_in != 22 || out_size != M * D || ws_size < WS_END) { fprintf(stderr, "kernel_launch: unexpected shapes (n_in %d out %d ws %zu)\n", n_in, out_size, ws_size); grid = -1; return; }
        int dev = 0, cus = 0, per_cu = 0;
        (void)hipGetDevice(&dev);
        (void)hipDeviceGetAttribute(&cus, hipDeviceAttributeMultiprocessorCount, dev);
        if (hipFuncSetAttribute((const void*)mega_fwd, hipFuncAttributeMaxDynamicSharedMemorySize, LDS_BYTES) != hipSuccess) { fprintf(stderr, "kernel_launch: hipFuncSetAttribute failed\n"); grid = -1; return; }
        if (hipOccupancyMaxActiveBlocksPerMultiprocessor(&per_cu, (const void*)mega_fwd, NTHREADS, LDS_BYTES) != hipSuccess || per_cu < 1) { fprintf(stderr, "kernel_launch: occupancy query gave %d\n", per_cu); per_cu = 1; }
        (void)hipGetLastError();
        grid = cus * per_cu;
        if (grid != 256) { fprintf(stderr, "kernel_launch: this kernel is built for 256 co-resident workgroups (got %d x %d)\n", cus, per_cu); if (grid < 256) { grid = -1; return; } grid = 256; }
    }
    if (grid < 0) return;
    if (hipMemsetAsync((char*)d_ws + WS_CTL, 0, 4096, stream) != hipSuccess) { fprintf(stderr, "kernel_launch: memset failed\n"); return; }
    Args a{};
    for (int i = 0; i < 22; ++i) a.in[i] = (const float*)d_in[i];
    a.out = (float*)d_out; a.ws = (unsigned char*)d_ws;
    void* args[] = {&a};
    hipError_t e = hipLaunchCooperativeKernel((const void*)mega_fwd, dim3(grid), dim3(NTHREADS), args, LDS_BYTES, stream);
    if (e != hipSuccess) fprintf(stderr, "kernel_launch: cooperative launch failed: %s (grid %d)\n", hipGetErrorString(e), grid);
}
```

```cpp
#include <hip/hip_runtime.h>
#include <hip/hip_cooperative_groups.h>
#include <cstdio>
#include <cstdint>
namespace cg = cooperative_groups;

#define LAS __attribute__((address_space(3)))
typedef unsigned short bf16_t;
typedef short bf16x8 __attribute__((ext_vector_type(8)));
typedef float f32x4 __attribute__((ext_vector_type(4)));
typedef float f32x2 __attribute__((ext_vector_type(2)));
typedef unsigned u32x4 __attribute__((ext_vector_type(4)));
typedef unsigned u32x2 __attribute__((ext_vector_type(2)));

constexpr int NB = 16, T = 2048, D = 1024, M = NB * T, FF = 2816, ZW = 5120, MEM = 256, MROWS = NB * MEM;
constexpr float EPS = 1e-6f;
constexpr int NTHREADS = 512;
constexpr int LDS_BYTES = 147456;

constexpr size_t MiB = 1u << 20;
constexpr size_t WS_PART = 0;
constexpr size_t WS_STAT = 2 * MiB;
constexpr size_t WS_WM = 10 * MiB;
constexpr size_t WS_MEMN = 11 * MiB;
constexpr size_t WS_KB = 19 * MiB;
constexpr size_t WS_W1IN = 35 * MiB;
constexpr size_t WS_W1OUT = 46 * MiB;
constexpr size_t WS_W2IN = 52 * MiB;
constexpr size_t WS_W2OUT = 63 * MiB;
constexpr size_t WS_WKV = 69 * MiB;
constexpr size_t WS_WIN = 73 * MiB;
constexpr size_t WS_WOUT = 83 * MiB;
constexpr size_t WS_XB = 90 * MiB;
constexpr size_t WS_Z = 154 * MiB;
constexpr size_t WS_CTL = 474 * MiB;
constexpr size_t WS_VT = 475 * MiB;
constexpr size_t WS_W2IN1 = 483 * MiB;
constexpr size_t WS_W2OUT1 = 494 * MiB;
constexpr size_t WS_WOUT1 = 500 * MiB;
constexpr size_t WS_END = 506 * MiB;

typedef __bf16 bf16x2_t __attribute__((ext_vector_type(2)));
__device__ __forceinline__ unsigned pk2(float lo, float hi) { f32x2 v = {lo, hi}; bf16x2_t r = __builtin_convertvector(v, bf16x2_t); return __builtin_bit_cast(unsigned, r); }
__device__ __forceinline__ float bf2f(unsigned short b) { return __uint_as_float(((unsigned)b) << 16); }
__device__ __forceinline__ float bflo(unsigned w) { return __uint_as_float(w << 16); }
__device__ __forceinline__ float bfhi(unsigned w) { return __uint_as_float(w & 0xffff0000u); }
__device__ __forceinline__ float fast_rcp(float x) { return __builtin_amdgcn_rcpf(x); }
__device__ __forceinline__ float silu_f(float x) { return x * fast_rcp(1.0f + __expf(-x)); }
__device__ __forceinline__ float shx(float v, int mask, int lane) { return __builtin_bit_cast(float, __builtin_amdgcn_ds_bpermute((lane ^ mask) << 2, __builtin_bit_cast(int, v))); }
__device__ __forceinline__ float wave_sum(float v, int lane) {
#pragma unroll
    for (int o = 1; o < 64; o <<= 1) v += shx(v, o, lane);
    return v;
}
__device__ __forceinline__ int lane_id() { int r; asm volatile("v_mbcnt_lo_u32_b32 %0, -1, 0\n\tv_mbcnt_hi_u32_b32 %0, -1, %0" : "=v"(r)); return r; }
__device__ __forceinline__ int opaque_vv(int x) { asm volatile("" : "+v"(x)); return x; }
__device__ __forceinline__ int opaque_s(int x) { asm volatile("" : "+s"(x)); return x; }
#define WG_BAR() do { asm volatile("s_waitcnt lgkmcnt(0)" ::: "memory"); __builtin_amdgcn_s_barrier(); asm volatile("" ::: "memory"); } while (0)
#define LDS_WAIT() asm volatile("s_waitcnt lgkmcnt(0)" ::: "memory")
#define VM_WAIT() asm volatile("s_waitcnt vmcnt(0)" ::: "memory")
__device__ __forceinline__ f32x4 mfma16(bf16x8 x, bf16x8 y, f32x4 acc) { return __builtin_amdgcn_mfma_f32_16x16x32_bf16(x, y, acc, 0, 0, 0); }

__device__ __forceinline__ float gelu_f(float v) {
    const float av = fabsf(v), d = av * 0.2316418882f + 1.0f;
    const float t = fast_rcp(d);
    float q = t * 0.5307027145f + (-0.7265760135f); q = q * t + 0.7107068705f; q = q * t + (-0.142248368f); q = q * t + 0.127414796f; q = q * t;
    const float e = __builtin_amdgcn_exp2f((v * v) * (-0.72134752044f));
    const float m = v * (q * e), r = v - m;
    return v < 0.f ? m : r;
}

__device__ __forceinline__ f32x2 sigmoid_pk(f32x2 x) {
    const f32x2 xc = __builtin_elementwise_max(x, (f32x2){-30.f, -30.f});
    const f32x2 t = xc * (-1.4426950408889634f);
    f32x2 e; e.x = __builtin_amdgcn_exp2f(t.x); e.y = __builtin_amdgcn_exp2f(t.y);
    const f32x2 d = e + 1.0f;
    const float r = fast_rcp(d.x * d.y);
    return (f32x2){r * d.y, r * d.x};
}
__device__ __forceinline__ f32x2 gelu_pk(f32x2 v) {
    const f32x2 av = __builtin_elementwise_abs(v), d = av * 0.2316418882f + 1.0f;
    f32x2 t; t.x = fast_rcp(d.x); t.y = fast_rcp(d.y);
    f32x2 q = t * 0.5307027145f + (-0.7265760135f); q = q * t + 0.7107068705f; q = q * t + (-0.142248368f); q = q * t + 0.127414796f; q = q * t;
    const f32x2 sq = (v * v) * (-0.72134752044f);
    f32x2 e; e.x = __builtin_amdgcn_exp2f(sq.x); e.y = __builtin_amdgcn_exp2f(sq.y);
    const f32x2 m = v * (q * e), r = v - m;
    f32x2 o; o.x = v.x < 0.f ? m.x : r.x; o.y = v.y < 0.f ? m.y : r.y; return o;
}

namespace pg8 {
constexpr int BM = 256, BK = 64, HALF = 128, HTB = HALF * BK * 2, STAGE_BYTES = 8 * HTB, NXCD = 8, WGM = 8;
__host__ __device__ __forceinline__ int lds_byte(int r, int c) { const int st = (r >> 4) * 2 + (c >> 5), rr = r & 15, cc = c & 31, ob = rr * 64 + cc * 2; return st * 1024 + (ob ^ (((ob >> 9) & 1) << 5)); }
__host__ __device__ __forceinline__ void stage_rc(int b, int& R, int& C) { const int st = b / 1024, sb = b % 1024, swz = sb ^ (((sb >> 9) & 1) << 5); R = (st >> 1) * 16 + swz / 64; C = (st & 1) * 32 + (swz % 64) / 2; }
__host__ __device__ __forceinline__ int perm32(int rho) { const int n = rho >> 4, i = rho & 15; return 8 * (i >> 2) + 4 * n + (i & 3); }

struct Unit { int pm, pn; };
struct Gemm { const bf16_t* A; const bf16_t* Bt; int lda, ldb, K; };

struct StaticOrder {
    int nM, nN, nwg, G, c;
    __device__ void init(int M_, int N_, int G_, int c_) { nM = M_ / BM; nN = N_ / BM; nwg = nM * nN; G = G_; c = c_; }
    __device__ bool next(int i, Unit& u) const {
        const long L = (long)i * G + c; if (L >= nwg) return false;
        int wgid = (int)L; { const int q = nwg / NXCD, r = nwg % NXCD, xcd = wgid % NXCD, off = wgid / NXCD; wgid = (xcd < r ? xcd * (q + 1) : r * (q + 1) + (xcd - r) * q) + off; }
        const int nig = WGM * nN, gid = wgid / nig, fm = gid * WGM, gsz = (nM - fm) < WGM ? (nM - fm) : WGM;
        u.pm = fm + ((wgid % nig) % gsz); u.pn = (wgid % nig) / gsz; return true;
    }
    __device__ __forceinline__ const char* aptr(const Gemm& g, const Unit& u) const { return (const char*)g.A + (size_t)u.pm * BM * g.lda * 2; }
    __device__ __forceinline__ const char* bptr(const Gemm& g, const Unit& u) const { return (const char*)g.Bt + (size_t)u.pn * BM * g.ldb * 2; }
};
struct FixedUnit {
    Unit u; bool has;
    __device__ bool next(int i, Unit& o) const { if (i != 0 || !has) return false; o = u; return true; }
    __device__ __forceinline__ const char* aptr(const Gemm& g, const Unit& v) const { return (const char*)g.A + (size_t)v.pm * BM * g.lda * 2; }
    __device__ __forceinline__ const char* bptr(const Gemm& g, const Unit& v) const { return (const char*)g.Bt + (size_t)v.pn * BM * g.ldb * 2; }
};
struct OneUnit {
    Unit u;
    __device__ bool next(int i, Unit& o) const { if (i != 0) return false; o = u; return true; }
    __device__ __forceinline__ const char* aptr(const Gemm& g, const Unit&) const { return (const char*)g.A; }
    __device__ __forceinline__ const char* bptr(const Gemm& g, const Unit&) const { return (const char*)g.Bt; }
};

template <class Epi, class Sched, bool ALIGN_EPI>
__device__ __forceinline__ void gemm_phase(LAS unsigned char* lds, const Gemm g, const Sched& S, const Epi& E, int wid0) {
    const int wid = opaque_s(wid0), lane = lane_id(), tid = wid * 64 + lane, wr = wid >> 2, wc = wid & 3, fr = lane & 15, fq = lane >> 4;
    const int K = g.K, nt = K / BK;
    unsigned voffA[2], voffB[2];
#pragma unroll
    for (int i = 0; i < 2; ++i) { int R, C; stage_rc(tid * 16 + i * 8192, R, C); const int Rb = Epi::PERM ? ((R & ~31) + perm32(R & 31)) : R;
        voffA[i] = (unsigned)(R * g.lda + C) * 2u; voffB[i] = (unsigned)(Rb * g.ldb + C) * 2u; }
    const size_t kstep = (size_t)(BK * 2);
    const size_t hstepA = (size_t)HALF * g.lda * 2, hstepB = (size_t)HALF * g.ldb * 2;
    const unsigned ldsw = (unsigned)wid * 1024u;
    const int aoff = lds_byte(wr * 64 + fr, fq * 8), boff = lds_byte(wc * 32 + fr, fq * 8);
#define PG8_SA(b, h) (((b) * 2 + (h)) * HTB)
#define PG8_SB(b, h) ((4 + (b) * 2 + (h)) * HTB)
#define PG8_STAGE(bufoff, gbase, voff) do { _Pragma("unroll") for (int _i = 0; _i < 2; ++_i) \
        __builtin_amdgcn_global_load_lds((const unsigned*)((const char*)(gbase) + (voff)[_i]), (LAS unsigned*)(lds + (bufoff) + ldsw + _i * 8192), 16, 0, 0); } while (0)
#define PG8_LDA(dst, b, h) do { _Pragma("unroll") for (int m = 0; m < 4; ++m) _Pragma("unroll") for (int k = 0; k < 2; ++k) dst[m][k] = *(const LAS bf16x8*)(lds + PG8_SA(b, h) + aoff + m * 2048 + k * 1024); } while (0)
#define PG8_LDB(dst, b, h) do { _Pragma("unroll") for (int n = 0; n < 2; ++n) _Pragma("unroll") for (int k = 0; k < 2; ++k) dst[n][k] = *(const LAS bf16x8*)(lds + PG8_SB(b, h) + boff + n * 2048 + k * 1024); } while (0)
#define PG8_MMA(ai, bj, At, Bt) do { __builtin_amdgcn_s_setprio(1); _Pragma("unroll") for (int m = 0; m < 4; ++m) _Pragma("unroll") for (int n = 0; n < 2; ++n) _Pragma("unroll") for (int k = 0; k < 2; ++k) \
        acc[ai][bj][m][n] = __builtin_amdgcn_mfma_f32_16x16x32_bf16(Bt[n][k], At[m][k], acc[ai][bj][m][n], 0, 0, 0); __builtin_amdgcn_s_setprio(0); } while (0)
#define PG8_WAIT_V(n) asm volatile("s_waitcnt vmcnt(" #n ")" ::: "memory")
#define PG8_WAIT_L(n) asm volatile("s_waitcnt lgkmcnt(" #n ")" ::: "memory")
#define PG8_BAR __builtin_amdgcn_s_barrier()
#define PG8_SCHED __builtin_amdgcn_sched_barrier(0)
    Unit cur, nxt; int ui = 0;
    if (!S.next(0, cur)) return;
    f32x4 acc[2][2][4][2];
#pragma unroll
    for (int a = 0; a < 2; ++a)
#pragma unroll
        for (int b = 0; b < 2; ++b)
#pragma unroll
            for (int m = 0; m < 4; ++m)
#pragma unroll
                for (int n = 0; n < 2; ++n) acc[a][b][m][n] = (f32x4){0.f, 0.f, 0.f, 0.f};
    bf16x8 At[4][2], B0[2][2], B1[2][2];
    const char* cA = S.aptr(g, cur); const char* cB = S.bptr(g, cur);
    PG8_STAGE(PG8_SB(0, 0), cB, voffB); PG8_STAGE(PG8_SB(0, 1), cB + hstepB, voffB); PG8_STAGE(PG8_SA(0, 0), cA, voffA); PG8_STAGE(PG8_SA(0, 1), cA + hstepA, voffA);
    if (wr == 1) PG8_BAR;
    PG8_WAIT_V(2); PG8_BAR;
    PG8_STAGE(PG8_SB(1, 0), cB + kstep, voffB); PG8_STAGE(PG8_SA(1, 0), cA + kstep, voffA); PG8_STAGE(PG8_SB(1, 1), cB + hstepB + kstep, voffB);
    PG8_WAIT_V(6); PG8_BAR;
    for (;;) {
        const bool has_next = S.next(ui + 1, nxt);
        const char* nA = has_next ? S.aptr(g, nxt) : cA; const char* nB = has_next ? S.bptr(g, nxt) : cB;
        for (int t = 0; t < nt; t += 2) {
            const bool last = (t == nt - 2);
            const char* a1 = cA + (size_t)(t + 1) * kstep;
            const char* a2 = last ? nA : cA + (size_t)(t + 2) * kstep; const char* b2 = last ? nB : cB + (size_t)(t + 2) * kstep;
            const char* a3 = a2 + kstep; const char* b3 = b2 + kstep;
            PG8_LDB(B0, 0, 0); PG8_LDB(B1, 0, 1); PG8_SCHED; PG8_LDA(At, 0, 0); PG8_STAGE(PG8_SA(1, 1), a1 + hstepA, voffA);
            PG8_WAIT_V(8); PG8_WAIT_L(0); PG8_BAR; PG8_MMA(0, 0, At, B0); PG8_MMA(0, 1, At, B1); PG8_BAR; PG8_SCHED;
            PG8_LDA(At, 0, 1); PG8_STAGE(PG8_SB(0, 0), b2, voffB); PG8_STAGE(PG8_SB(0, 1), b2 + hstepB, voffB); PG8_STAGE(PG8_SA(0, 0), a2, voffA);
            PG8_WAIT_V(8); PG8_WAIT_L(0); PG8_BAR; PG8_MMA(1, 0, At, B0); PG8_MMA(1, 1, At, B1); PG8_BAR; PG8_SCHED;
            PG8_LDB(B0, 1, 0); PG8_LDB(B1, 1, 1); PG8_SCHED; PG8_LDA(At, 1, 0); PG8_STAGE(PG8_SA(0, 1), a2 + hstepA, voffA);
            PG8_WAIT_V(8); PG8_WAIT_L(0); PG8_BAR; PG8_MMA(0, 0, At, B0); PG8_MMA(0, 1, At, B1); PG8_BAR; PG8_SCHED;
            PG8_LDA(At, 1, 1); PG8_STAGE(PG8_SB(1, 0), b3, voffB); PG8_STAGE(PG8_SB(1, 1), b3 + hstepB, voffB); PG8_STAGE(PG8_SA(1, 0), a3, voffA);
            PG8_WAIT_V(8); PG8_WAIT_L(0); PG8_BAR; PG8_MMA(1, 0, At, B0); PG8_MMA(1, 1, At, B1); PG8_BAR; PG8_SCHED;
        }
        if constexpr (ALIGN_EPI) { if (wr == 0) PG8_BAR; }
        if constexpr (!Epi::AFTER_DRAIN) { E(acc, cur, wr, wc, fr, fq); }
        if (!has_next) break;
#pragma unroll
        for (int a = 0; a < 2; ++a)
#pragma unroll
            for (int b = 0; b < 2; ++b)
#pragma unroll
                for (int m = 0; m < 4; ++m)
#pragma unroll
                    for (int n = 0; n < 2; ++n) acc[a][b][m][n] = (f32x4){0.f, 0.f, 0.f, 0.f};
        cur = nxt; cA = nA; cB = nB; ++ui;
        if constexpr (ALIGN_EPI) { if (wr == 1) PG8_BAR; }
    }
    PG8_WAIT_V(0);
    if constexpr (!ALIGN_EPI) { if (wr == 0) PG8_BAR; }
    PG8_BAR;
    if constexpr (Epi::AFTER_DRAIN) { E.fused(acc, cur, wr, wc, fr, fq, lds, wid, lane); }
#undef PG8_SA
#undef PG8_SB
#undef PG8_STAGE
#undef PG8_LDA
#undef PG8_LDB
#undef PG8_MMA
#undef PG8_WAIT_V
#undef PG8_WAIT_L
#undef PG8_BAR
#undef PG8_SCHED
}

__device__ __forceinline__ float row_rstd(const float* part, int r) {
    const f32x4* p = (const f32x4*)(part + (size_t)r * 16);
    const f32x4 a = p[0], b = p[1], c = p[2], d = p[3];
    const float s = ((a[0] + a[1]) + (a[2] + a[3])) + ((b[0] + b[1]) + (b[2] + b[3])) + ((c[0] + c[1]) + (c[2] + c[3])) + ((d[0] + d[1]) + (d[2] + d[3]));
    return 1.0f / sqrtf(s * (1.0f / 1024.0f) + EPS);
}

__device__ __forceinline__ void load_rstd8(const float* part, int row0, int fq, int lane, float (&rs)[8]) {
    f32x4 p[8];
#pragma unroll
    for (int i = 0; i < 8; ++i) p[i] = *(const f32x4*)(part + (size_t)(row0 + (i >> 2) * HALF + (i & 3) * 16) * 16 + fq * 4);
#pragma unroll
    for (int i = 0; i < 8; ++i) { float s = (p[i][0] + p[i][1]) + (p[i][2] + p[i][3]); s += shx(s, 16, lane); s += shx(s, 32, lane); rs[i] = __builtin_amdgcn_rsqf(s * (1.0f / 1024.0f) + EPS); }
}

struct EpiSwiglu {
    static constexpr bool PERM = true, AFTER_DRAIN = false;
    bf16_t* H; const float* part;
    __device__ __forceinline__ void operator()(const f32x4 (&acc)[2][2][4][2], const Unit& u, int wr, int wc, int fr, int fq) const {
        const int row0 = u.pm * BM + wr * 64 + fr, col0 = u.pn * 128 + wc * 32 + 8 * fq;
        float rsv[8]; load_rstd8(part, row0, fq, fq * 16 + fr, rsv);
#pragma unroll
        for (int ai = 0; ai < 2; ++ai)
#pragma unroll
            for (int m = 0; m < 4; ++m) {
                const int r = row0 + ai * HALF + m * 16; const float rs = rsv[ai * 4 + m];
                f32x2 h[4];
#pragma unroll
                for (int n = 0; n < 2; ++n)
#pragma unroll
                    for (int j = 0; j < 4; j += 2) {
                        const f32x2 gt = (f32x2){acc[ai][0][m][n][j], acc[ai][0][m][n][j + 1]} * rs, up = (f32x2){acc[ai][1][m][n][j], acc[ai][1][m][n][j + 1]} * rs;
                        h[n * 2 + (j >> 1)] = gt * sigmoid_pk(gt) * up;
                    }
                u32x4 w; w.x = pk2(h[0].x, h[0].y); w.y = pk2(h[1].x, h[1].y); w.z = pk2(h[2].x, h[2].y); w.w = pk2(h[3].x, h[3].y);
                __builtin_nontemporal_store(w, (u32x4*)(H + (size_t)r * ZW + col0));
            }
    }
};

struct EpiResid {
    static constexpr bool PERM = true, AFTER_DRAIN = false;
    const float* xin32; bf16_t* xb; float* part; float s;
    __device__ __forceinline__ void operator()(const f32x4 (&acc)[2][2][4][2], const Unit& u, int wr, int wc, int fr, int fq) const {
        const int row0 = u.pm * BM + wr * 64 + fr, col0 = u.pn * BM + wc * 32 + 8 * fq;
        u32x4 wx[2][4][2];
        if (!xin32) {
#pragma unroll
            for (int ai = 0; ai < 2; ++ai)
#pragma unroll
                for (int m = 0; m < 4; ++m)
#pragma unroll
                    for (int bj = 0; bj < 2; ++bj) wx[ai][m][bj] = *(const u32x4*)(xb + (size_t)(row0 + ai * HALF + m * 16) * D + col0 + bj * HALF);
            asm volatile("" ::: "memory");
        }
#pragma unroll
        for (int ai = 0; ai < 2; ++ai)
#pragma unroll
            for (int m = 0; m < 4; ++m) {
                const int r = row0 + ai * HALF + m * 16; float ss = 0.f;
#pragma unroll
                for (int bj = 0; bj < 2; ++bj) {
                    const size_t off = (size_t)r * D + col0 + bj * HALF;
                    f32x4 a, b;
                    if (xin32) { a = *(const f32x4*)(xin32 + off); b = *(const f32x4*)(xin32 + off + 4); }
                    else { const u32x4 w = wx[ai][m][bj]; a = (f32x4){bflo(w.x), bfhi(w.x), bflo(w.y), bfhi(w.y)}; b = (f32x4){bflo(w.z), bfhi(w.z), bflo(w.w), bfhi(w.w)}; }
                    a = a + acc[ai][bj][m][0] * s; b = b + acc[ai][bj][m][1] * s;
                    ss += (a[0] * a[0] + a[1] * a[1]) + (a[2] * a[2] + a[3] * a[3]) + (b[0] * b[0] + b[1] * b[1]) + (b[2] * b[2] + b[3] * b[3]);
                    u32x4 w2; w2.x = pk2(a[0], a[1]); w2.y = pk2(a[2], a[3]); w2.z = pk2(b[0], b[1]); w2.w = pk2(b[2], b[3]);
                    *(u32x4*)(xb + off) = w2;
                }
                ss += shx(ss, 16, (fq * 16 + fr)); ss += shx(ss, 32, (fq * 16 + fr));
                if (fq == 0) part[(size_t)r * 16 + u.pn * 4 + wc] = ss;
            }
    }
};

struct EpiZ {
    static constexpr bool PERM = true, AFTER_DRAIN = false;
    bf16_t* Z; const float* part; float* stat; int mode;
    __device__ __forceinline__ void operator()(const f32x4 (&acc)[2][2][4][2], const Unit& u, int wr, int wc, int fr, int fq) const {
        const int row0 = u.pm * BM + wr * 64 + fr, col0 = u.pn * BM + wc * 32 + 8 * fq;
        const int sec = u.pn >> 2;
        int act;
        if (mode == 0) act = (sec == 0 || sec == 4) ? 1 : (sec == 1 ? 3 : 0);
        else act = (sec == 2) ? 3 : 2;
        const bool dostat = (mode == 1) && (sec >= 3);
        float rsv[8]; load_rstd8(part, row0, fq, fq * 16 + fr, rsv);
#pragma unroll
        for (int ai = 0; ai < 2; ++ai)
#pragma unroll
            for (int m = 0; m < 4; ++m) {
                const int r = row0 + ai * HALF + m * 16; const float rs = rsv[ai * 4 + m];
                float sm = 0.f, sq = 0.f;
#pragma unroll
                for (int bj = 0; bj < 2; ++bj) {
                    float v[8];
#pragma unroll
                    for (int n = 0; n < 2; ++n)
#pragma unroll
                        for (int j = 0; j < 4; j += 2) {
                            f32x2 x = (f32x2){acc[ai][bj][m][n][j], acc[ai][bj][m][n][j + 1]} * rs;
                            if (act == 1) x = x * sigmoid_pk(x); else if (act == 2) x = gelu_pk(x); else if (act == 3) x = x * 0.0625f;
                            v[n * 4 + j] = x.x; v[n * 4 + j + 1] = x.y; sm += x.x + x.y; sq += x.x * x.x + x.y * x.y;
                        }
                    u32x4 w; w.x = pk2(v[0], v[1]); w.y = pk2(v[2], v[3]); w.z = pk2(v[4], v[5]); w.w = pk2(v[6], v[7]);
                    __builtin_nontemporal_store(w, (u32x4*)(Z + (size_t)r * ZW + col0 + bj * HALF));
                }
                if (dostat) {
                    sm += shx(sm, 16, (fq * 16 + fr)); sm += shx(sm, 32, (fq * 16 + fr)); sq += shx(sq, 16, (fq * 16 + fr)); sq += shx(sq, 32, (fq * 16 + fr));
                    if (fq == 0) *(f32x2*)(stat + (size_t)r * 64 + ((u.pn - 12) * 4 + wc) * 2) = (f32x2){sm, sq};
                }
            }
    }
};

struct EpiPlain {
    static constexpr bool PERM = true, AFTER_DRAIN = false;
    bf16_t* O; int ldo;
    __device__ __forceinline__ void operator()(const f32x4 (&acc)[2][2][4][2], const Unit& u, int wr, int wc, int fr, int fq) const {
        const int row0 = u.pm * BM + wr * 64 + fr, col0 = u.pn * BM + wc * 32 + 8 * fq;
#pragma unroll
        for (int ai = 0; ai < 2; ++ai)
#pragma unroll
            for (int m = 0; m < 4; ++m)
#pragma unroll
                for (int bj = 0; bj < 2; ++bj) {
                    const f32x4 a = acc[ai][bj][m][0], b = acc[ai][bj][m][1];
                    u32x4 w; w.x = pk2(a[0], a[1]); w.y = pk2(a[2], a[3]); w.z = pk2(b[0], b[1]); w.w = pk2(b[2], b[3]);
                    *(u32x4*)(O + (size_t)(row0 + ai * HALF + m * 16) * ldo + col0 + bj * HALF) = w;
                }
    }
};

struct EpiSoftmax {
    static constexpr bool PERM = true, AFTER_DRAIN = true;
    bf16_t* O; int ldo;
    __device__ __forceinline__ void fused(f32x4 (&acc)[2][2][4][2], const Unit&, int wr, int wc, int fr, int fq, LAS unsigned char* lds, int wid, int lane) const {
        LAS float* R1 = (LAS float*)lds;
        LAS float* R2 = (LAS float*)(lds + 4096);
#pragma unroll
        for (int ai = 0; ai < 2; ++ai)
#pragma unroll
            for (int m = 0; m < 4; ++m) {
                float mx = -3.0e38f;
#pragma unroll
                for (int bj = 0; bj < 2; ++bj)
#pragma unroll
                    for (int n = 0; n < 2; ++n)
#pragma unroll
                        for (int j = 0; j < 4; ++j) mx = fmaxf(mx, acc[ai][bj][m][n][j]);
                mx = fmaxf(mx, shx(mx, 16, (fq * 16 + fr))); mx = fmaxf(mx, shx(mx, 32, (fq * 16 + fr)));
                if (fq == 0) R1[wc * 256 + ai * HALF + wr * 64 + m * 16 + fr] = mx;
            }
        LDS_WAIT(); __builtin_amdgcn_s_barrier(); asm volatile("" ::: "memory");
#pragma unroll
        for (int ai = 0; ai < 2; ++ai)
#pragma unroll
            for (int m = 0; m < 4; ++m) {
                const int rl = ai * HALF + wr * 64 + m * 16 + fr;
                const float mx = fmaxf(fmaxf(R1[rl], R1[256 + rl]), fmaxf(R1[512 + rl], R1[768 + rl]));
                float sm = 0.f;
#pragma unroll
                for (int bj = 0; bj < 2; ++bj)
#pragma unroll
                    for (int n = 0; n < 2; ++n)
#pragma unroll
                        for (int j = 0; j < 4; ++j) { const float p = __expf(acc[ai][bj][m][n][j] - mx); acc[ai][bj][m][n][j] = p; sm += p; }
                sm += shx(sm, 16, (fq * 16 + fr)); sm += shx(sm, 32, (fq * 16 + fr));
                if (fq == 0) R2[wc * 256 + rl] = sm;
            }
        LDS_WAIT(); __builtin_amdgcn_s_barrier(); asm volatile("" ::: "memory");
        const int row0 = wr * 64 + fr, col0 = wc * 32 + 8 * fq;
#pragma unroll
        for (int ai = 0; ai < 2; ++ai)
#pragma unroll
            for (int m = 0; m < 4; ++m) {
                const int rl = ai * HALF + wr * 64 + m * 16 + fr;
                const float inv = 1.0f / ((R2[rl] + R2[256 + rl]) + (R2[512 + rl] + R2[768 + rl]));
#pragma unroll
                for (int bj = 0; bj < 2; ++bj) {
                    const f32x4 a = acc[ai][bj][m][0] * inv, b = acc[ai][bj][m][1] * inv;
                    u32x4 w; w.x = pk2(a[0], a[1]); w.y = pk2(a[2], a[3]); w.z = pk2(b[0], b[1]); w.w = pk2(b[2], b[3]);
                    *(u32x4*)(O + (size_t)(row0 + ai * HALF + m * 16) * ldo + col0 + bj * HALF) = w;
                }
            }
        LDS_WAIT(); __builtin_amdgcn_s_barrier(); asm volatile("" ::: "memory");
    }
};
}

__device__ __forceinline__ int map_row(int kind, int n) {
    if (kind == 1) { const int half = n >= FF ? 1 : 0; const int i = n - half * FF; return (i >> 7) * 256 + half * 128 + (i & 127); }
    if (kind == 2) { const int s = n >> 10; const int ds = (s == 0) ? 0 : (s == 4 ? 1 : s + 1); return ds * 1024 + (n & 1023); }
    if (kind == 3) { return n < 2048 ? n : (n < 4096 ? n + 1024 : n - 2048); }
    return n;
}
__device__ __forceinline__ void transpose_mat(LAS unsigned char* lds, const float* W, const float* gain, bf16_t* WT, int K, int N, int kind, int gw, int ngw, int wid, int lane) {
    LAS float* scr = (LAS float*)(lds + wid * 16384);
    const int nblk = N / 32, items = (K / 64) * nblk;
    if (gw >= items) return;
    float wv[32];
    {
        const int kb = gw / nblk, nb = gw - kb * nblk;
#pragma unroll
        for (int i = 0; i < 32; ++i) wv[i] = W[(size_t)(kb * 64 + 2 * i + (lane >> 5)) * N + nb * 32 + (lane & 31)];
    }
    for (int it = gw; it < items; it += ngw) {
        const int kb = it / nblk, nb = it - kb * nblk, k0 = kb * 64, n0 = nb * 32;
        const int c = lane & 7;
        f32x4 ga = (f32x4){1.f, 1.f, 1.f, 1.f}, gb = ga;
        if (gain) { ga = *(const f32x4*)(gain + k0 + 8 * c); gb = *(const f32x4*)(gain + k0 + 8 * c + 4); }
#pragma unroll
        for (int i = 0; i < 32; ++i) scr[(2 * i + (lane >> 5)) * 33 + (lane & 31)] = wv[i];
        const int nx = it + ngw;
        if (nx < items) {
            const int kb2 = nx / nblk, nb2 = nx - kb2 * nblk;
#pragma unroll
            for (int i = 0; i < 32; ++i) wv[i] = W[(size_t)(kb2 * 64 + 2 * i + (lane >> 5)) * N + nb2 * 32 + (lane & 31)];
        }
        LDS_WAIT(); asm volatile("" ::: "memory");
        const int drow0 = map_row(kind, n0);
#pragma unroll
        for (int j = 0; j < 4; ++j) { const int n = (lane >> 3) + 8 * j; const LAS float* sp = scr + (8 * c) * 33 + n;
            u32x4 o; o.x = pk2(sp[0 * 33] * ga[0], sp[1 * 33] * ga[1]); o.y = pk2(sp[2 * 33] * ga[2], sp[3 * 33] * ga[3]); o.z = pk2(sp[4 * 33] * gb[0], sp[5 * 33] * gb[1]); o.w = pk2(sp[6 * 33] * gb[2], sp[7 * 33] * gb[3]);
            *(u32x4*)(WT + (size_t)(drow0 + n) * K + k0 + 8 * c) = o; }
        LDS_WAIT(); asm volatile("" ::: "memory");
    }
}

__device__ __forceinline__ void hgrn_item(LAS unsigned char* lds, bf16_t* Z, const float* lb_logits, const float* gnorm, int b, int h, int wid0) {
    const int wid = opaque_s(wid0), lane = lane_id(), tid = wid * 64 + lane, fr = lane & 15, fq = lane >> 4;
    lds += opaque_s(0);
    constexpr int QD_OFF = 0, RS272 = 272, KI_OFF = 17408, KDT_OFF = 34816, RS144 = 144, VT_OFF = 53248, A1_OFF = 71680, ST_OFF = 80896, MISC_OFF = 115712;
    LAS float* tot = (LAS float*)(lds + MISC_OFF);
    LAS float* bl = (LAS float*)(lds + MISC_OFF + 4096);
    LAS float* lbv = (LAS float*)(lds + MISC_OFF + 4608);
    LAS float* gnv = (LAS float*)(lds + MISC_OFF + 5120);
    LAS float* ssqp = (LAS float*)(lds + MISC_OFF + 5632);
    for (int i = tid; i < 34816 / 4; i += NTHREADS) ((LAS unsigned*)(lds + ST_OFF))[i] = 0u;
    if (tid < 128) {
        const int ch = h * 128 + tid;
        const float l0 = lb_logits[ch], l1 = lb_logits[1024 + ch], l2 = lb_logits[2048 + ch];
        const float mx = fmaxf(l0, fmaxf(l1, l2));
        const float e0 = __expf(l0 - mx), e1 = __expf(l1 - mx), e2 = __expf(l2 - mx);
        lbv[tid] = e0 / (e0 + e1 + e2);
        gnv[tid] = gnorm[tid];
    }
    f32x4 S[8];
#pragma unroll
    for (int i = 0; i < 8; ++i) S[i] = (f32x4){0.f, 0.f, 0.f, 0.f};
    LDS_WAIT(); __syncthreads();
    const int t0 = wid * 8;
    const f32x2 lb2 = *(const LAS f32x2*)(lbv + 2 * lane);
    const float oml0 = 1.0f - lb2[0], oml1 = 1.0f - lb2[1];
    const bf16_t* zbase = Z + ((size_t)b * T + t0) * ZW + h * 128 + 2 * lane;
    unsigned zfr[8], qr[8], vr[8];
#pragma unroll
    for (int i = 0; i < 8; ++i) { zfr[i] = *(const unsigned*)(zbase + (size_t)i * ZW + 2048); qr[i] = *(const unsigned*)(zbase + (size_t)i * ZW); vr[i] = *(const unsigned*)(zbase + (size_t)i * ZW + 3072); }
    const int tt2 = wid & 3, vh = wid >> 2;
    for (int n = 0; n < T / 64; ++n) {
        const size_t row0 = (size_t)b * T + (size_t)n * 64;
        bf16_t* orow = Z + (row0 + tt2 * 16 + fr) * ZW + h * 128;
        u32x2 gg[4];
#pragma unroll
        for (int i = 0; i < 4; ++i) gg[i] = *(const u32x2*)(orow + 4096 + (vh * 4 + i) * 16 + fq * 4);
        f32x2 lp[8], kk[8]; f32x2 cp = (f32x2){1.f, 1.f};
        const f32x2 oml2 = (f32x2){oml0, oml1};
#pragma unroll
        for (int i = 0; i < 8; ++i) {
            const f32x2 z = __builtin_elementwise_max((f32x2){bflo(zfr[i]), bfhi(zfr[i])}, (f32x2){-30.f, -30.f});
            const f32x2 t = z * (-1.4426950408889634f);
            f32x2 e; e.x = __builtin_amdgcn_exp2f(t.x); e.y = __builtin_amdgcn_exp2f(t.y);
            const f32x2 d = e + 1.0f;
            const float r = fast_rcp(d.x * d.y);
            const f32x2 sg = (f32x2){r * d.y, r * d.x};
            const f32x2 f = lb2 + oml2 * sg;
            kk[i] = oml2 * (e * sg);
            cp = cp * f; lp[i] = cp;
        }
        *(LAS f32x2*)(tot + wid * 128 + 2 * lane) = cp;
        WG_BAR();
        {
            f32x2 off = (f32x2){1.f, 1.f}, blp = (f32x2){1.f, 1.f};
#pragma unroll
            for (int j = 0; j < 8; ++j) { const f32x2 t2 = *(const LAS f32x2*)(tot + j * 128 + 2 * lane); if (j < wid) off = off * t2; blp = blp * t2; }
            float kd0[8], kd1[8];
#pragma unroll
            for (int i = 0; i < 8; ++i) {
                const f32x2 e = off * lp[i];
                f32x2 iv; iv.x = fast_rcp(e.x); iv.y = fast_rcp(e.y);
                const f32x2 q = (f32x2){bflo(qr[i]), bfhi(qr[i])} * e;
                const f32x2 ki = kk[i] * iv;
                const f32x2 kd = kk[i] * (blp * iv);
                *(LAS unsigned*)(lds + QD_OFF + (t0 + i) * RS272 + lane * 4) = pk2(q.x, q.y);
                *(LAS unsigned*)(lds + KI_OFF + (t0 + i) * RS272 + lane * 4) = pk2(ki.x, ki.y);
                kd0[i] = kd.x; kd1[i] = kd.y;
            }
            *(LAS u32x4*)(lds + KDT_OFF + (2 * lane) * RS144 + t0 * 2) = (u32x4){pk2(kd0[0], kd0[1]), pk2(kd0[2], kd0[3]), pk2(kd0[4], kd0[5]), pk2(kd0[6], kd0[7])};
            *(LAS u32x4*)(lds + KDT_OFF + (2 * lane + 1) * RS144 + t0 * 2) = (u32x4){pk2(kd1[0], kd1[1]), pk2(kd1[2], kd1[3]), pk2(kd1[4], kd1[5]), pk2(kd1[6], kd1[7])};
            *(LAS u32x4*)(lds + VT_OFF + (2 * lane) * RS144 + t0 * 2) = (u32x4){(vr[0] & 0xffffu) | (vr[1] << 16), (vr[2] & 0xffffu) | (vr[3] << 16), (vr[4] & 0xffffu) | (vr[5] << 16), (vr[6] & 0xffffu) | (vr[7] << 16)};
            *(LAS u32x4*)(lds + VT_OFF + (2 * lane + 1) * RS144 + t0 * 2) = (u32x4){(vr[0] >> 16) | (vr[1] & 0xffff0000u), (vr[2] >> 16) | (vr[3] & 0xffff0000u), (vr[4] >> 16) | (vr[5] & 0xffff0000u), (vr[6] >> 16) | (vr[7] & 0xffff0000u)};
            if (wid == 0) *(LAS f32x2*)(bl + 2 * lane) = blp;
        }
        if (n + 1 < T / 64) {
            zbase += (size_t)64 * ZW;
#pragma unroll
            for (int i = 0; i < 8; ++i) { zfr[i] = *(const unsigned*)(zbase + (size_t)i * ZW + 2048); qr[i] = *(const unsigned*)(zbase + (size_t)i * ZW); vr[i] = *(const unsigned*)(zbase + (size_t)i * ZW + 3072); }
        }
        WG_BAR();
        {
            const int tt = wid >> 1;
            bf16x8 Yq[4];
#pragma unroll
            for (int ks = 0; ks < 4; ++ks) Yq[ks] = *(const LAS bf16x8*)(lds + QD_OFF + (tt * 16 + fr) * RS272 + (ks * 32 + fq * 8) * 2);
#pragma unroll
            for (int si = 0; si < 2; ++si) {
                const int st = (wid & 1) * 2 + si;
                f32x4 a = (f32x4){0.f, 0.f, 0.f, 0.f};
                if (st <= tt) {
#pragma unroll
                    for (int ks = 0; ks < 4; ++ks) {
                        const bf16x8 X = *(const LAS bf16x8*)(lds + KI_OFF + (st * 16 + fr) * RS272 + (ks * 32 + fq * 8) * 2);
                        a = mfma16(X, Yq[ks], a);
                    }
                }
                const int t = tt * 16 + fr, s0 = st * 16 + fq * 4;
                float v[4];
#pragma unroll
                for (int j = 0; j < 4; ++j) v[j] = (s0 + j <= t) ? a[j] : 0.f;
                *(LAS u32x2*)(lds + A1_OFF + t * RS144 + s0 * 2) = (u32x2){pk2(v[0], v[1]), pk2(v[2], v[3])};
            }
        }
        WG_BAR();
        {
            const int tt = tt2;
            f32x4 o[4];
            float ss = 0.f;
            bf16x8 Ya[2], Yq[4];
#pragma unroll
            for (int ks = 0; ks < 2; ++ks) Ya[ks] = *(const LAS bf16x8*)(lds + A1_OFF + (tt * 16 + fr) * RS144 + (ks * 32 + fq * 8) * 2);
#pragma unroll
            for (int ks = 0; ks < 4; ++ks) Yq[ks] = *(const LAS bf16x8*)(lds + QD_OFF + (tt * 16 + fr) * RS272 + (ks * 32 + fq * 8) * 2);
#pragma unroll
            for (int i = 0; i < 4; ++i) {
                const int vt = vh * 4 + i;
                f32x4 a = (f32x4){0.f, 0.f, 0.f, 0.f};
#pragma unroll
                for (int ks = 0; ks < 2; ++ks) {
                    const bf16x8 X = *(const LAS bf16x8*)(lds + VT_OFF + (vt * 16 + fr) * RS144 + (ks * 32 + fq * 8) * 2);
                    a = mfma16(X, Ya[ks], a);
                }
#pragma unroll
                for (int ks = 0; ks < 4; ++ks) {
                    const bf16x8 X = *(const LAS bf16x8*)(lds + ST_OFF + (vt * 16 + fr) * RS272 + (ks * 32 + fq * 8) * 2);
                    a = mfma16(X, Yq[ks], a);
                }
                o[i] = a;
                ss += (a[0] * a[0] + a[1] * a[1]) + (a[2] * a[2] + a[3] * a[3]);
            }
            ss += shx(ss, 16, lane); ss += shx(ss, 32, lane);
            if (fq == 0) ssqp[vh * 64 + tt * 16 + fr] = ss;
            WG_BAR();
            const float tss = ssqp[tt * 16 + fr] + ssqp[64 + tt * 16 + fr];
            const float rs = __builtin_amdgcn_rsqf(tss * (1.0f / 128.0f) + EPS);
#pragma unroll
            for (int i = 0; i < 4; ++i) {
                const int v0 = (vh * 4 + i) * 16 + fq * 4;
                const f32x4 gn = *(const LAS f32x4*)(gnv + v0);
                const float r0 = o[i][0] * rs * gn[0] * bflo(gg[i].x), r1 = o[i][1] * rs * gn[1] * bfhi(gg[i].x);
                const float r2 = o[i][2] * rs * gn[2] * bflo(gg[i].y), r3 = o[i][3] * rs * gn[3] * bfhi(gg[i].y);
                __builtin_nontemporal_store((u32x2){pk2(r0, r1), pk2(r2, r3)}, (u32x2*)(orow + v0));
            }
        }
        {
            const f32x4 dec = *(const LAS f32x4*)(bl + wid * 16 + fq * 4);
            bf16x8 X[2];
#pragma unroll
            for (int ks = 0; ks < 2; ++ks) X[ks] = *(const LAS bf16x8*)(lds + KDT_OFF + (wid * 16 + fr) * RS144 + (ks * 32 + fq * 8) * 2);
#pragma unroll
            for (int vt = 0; vt < 8; ++vt) {
                f32x4 a = S[vt] * dec;
#pragma unroll
                for (int ks = 0; ks < 2; ++ks) {
                    const bf16x8 Y = *(const LAS bf16x8*)(lds + VT_OFF + (vt * 16 + fr) * RS144 + (ks * 32 + fq * 8) * 2);
                    a = mfma16(X[ks], Y, a);
                }
                S[vt] = a;
                *(LAS u32x2*)(lds + ST_OFF + (vt * 16 + fr) * RS272 + (wid * 16 + fq * 4) * 2) = (u32x2){pk2(a[0], a[1]), pk2(a[2], a[3])};
            }
        }
    }
    LDS_WAIT(); __syncthreads();
}

__device__ __forceinline__ void attn_unit(LAS unsigned char* lds, bf16_t* Zx  , const bf16_t* Kb, const bf16_t* Vt, int item, int wid0) {
    const int qt = item & 7, h = (item >> 3) & 3, b = item >> 5;
    bf16_t* q = Zx + ((size_t)b * T + (size_t)qt * 256) * ZW + h * 256;
    pg8::OneUnit S; S.u.pm = 0; S.u.pn = 0;
    {
        pg8::Gemm g{q, Kb + (size_t)b * 256 * 2048 + h * 256, ZW, 2048, 256};
        pg8::EpiSoftmax E{q, ZW};
        pg8::gemm_phase<pg8::EpiSoftmax, pg8::OneUnit, false>(lds, g, S, E, wid0);
    }
    asm volatile("s_waitcnt vmcnt(0)" ::: "memory"); __builtin_amdgcn_s_barrier(); asm volatile("" ::: "memory");
    if (opaque_s(wid0) == 0) { __builtin_amdgcn_fence(__ATOMIC_ACQUIRE, "agent"); asm volatile("s_waitcnt vmcnt(0)" ::: "memory"); }
    asm volatile("" ::: "memory"); __builtin_amdgcn_s_barrier(); asm volatile("" ::: "memory");
    {
        pg8::Gemm g{q, Vt + (size_t)((b * 4 + h) * 256) * 256, ZW, 256, 256};
        pg8::EpiPlain E{q, ZW};
        pg8::gemm_phase<pg8::EpiPlain, pg8::OneUnit, false>(lds, g, S, E, wid0);
    }
    asm volatile("" ::: "memory"); __builtin_amdgcn_s_barrier(); asm volatile("" ::: "memory");
}

#define GMLP_LOAD(IT_) do { const int g_ = (IT_) & 7; const size_t r0_ = (size_t)((IT_) >> 7) * T + (size_t)(((IT_) >> 3) & 15) * 128; \
        _Pragma("unroll") for (int q = 0; q < 4; ++q) sp[q] = *(const f32x4*)(stat + (r0_ + stok) * 64 + (sq4 * 4 + q) * 4); \
        _Pragma("unroll") for (int it2 = 0; it2 < 2; ++it2) _Pragma("unroll") for (int j = 0; j < 4; ++j) \
            w[it2][j] = *(const u32x4*)(Z + (r0_ + (tg0 + 16 * it2) * 4 + j) * ZW + 3072 + g_ * 256 + c0); } while (0)
__device__ __forceinline__ void gmlp_items(LAS unsigned char* lds0, bf16_t* Z, const float* stat, const float* ln_g, const float* ln_b, const bf16_t* Wm, const float* bs, int item0, int istep, int nitems, int wid0) {
    constexpr int VTS = 272;
    f32x4 sp[4]; u32x4 w[2][4];
    constexpr int WL_OFF = 70656, WLS = 272;
    {
        const int wid = opaque_s(wid0), lane = lane_id(), tid = wid * 64 + lane;
        const int tg0 = tid >> 5, c0 = (tid & 31) * 8, stok = tid >> 2, sq4 = tid & 3;
        const bf16_t* wgp = Wm + (size_t)(item0 & 7) * 128 * 128;
        u32x4 wm[4];
#pragma unroll
        for (int q = 0; q < 4; ++q) wm[q] = *(const u32x4*)(wgp + (size_t)(tid + q * NTHREADS) * 8);
#pragma unroll
        for (int q = 0; q < 4; ++q) { const int idx = tid + q * NTHREADS; *(LAS u32x4*)(lds0 + WL_OFF + (idx >> 4) * WLS + (idx & 15) * 16) = wm[q]; }
        GMLP_LOAD(item0);
    }
    for (int k = 0; k < nitems; ++k) {
        const int wid = opaque_s(wid0), lane = lane_id(), tid = wid * 64 + lane, fr = lane & 15, fq = lane >> 4;
        LAS unsigned char* lds = lds0 + opaque_s(0);
        LAS float* murs = (LAS float*)(lds + 69632);
        const int cg8 = tid & 31, tg0 = tid >> 5, c0 = cg8 * 8, stok = tid >> 2, sq4 = tid & 3;
        const int item = item0 + k * istep;
        const int g = item & 7, n = (item >> 3) & 15, b = item >> 7;
        const size_t row0 = (size_t)b * T + (size_t)n * 128;
        {
            float sm = 0.f, sq = 0.f;
#pragma unroll
            for (int q = 0; q < 4; ++q) { sm += sp[q][0] + sp[q][2]; sq += sp[q][1] + sp[q][3]; }
            sm += shx(sm, 1, lane); sm += shx(sm, 2, lane); sq += shx(sq, 1, lane); sq += shx(sq, 2, lane);
            const float mean = sm * (1.0f / 2048.0f);
            const float var = fmaxf(sq * (1.0f / 2048.0f) - mean * mean, 0.f);
            if (sq4 == 0) *(LAS f32x2*)(murs + stok * 2) = (f32x2){mean, __builtin_amdgcn_rsqf(var + EPS)};
        }
        WG_BAR();
        {
            const f32x4 g0 = *(const f32x4*)(ln_g + g * 256 + c0), g1 = *(const f32x4*)(ln_g + g * 256 + c0 + 4);
            const f32x4 b0 = *(const f32x4*)(ln_b + g * 256 + c0), b1 = *(const f32x4*)(ln_b + g * 256 + c0 + 4);
#pragma unroll
            for (int it2 = 0; it2 < 2; ++it2) {
                const int t0 = (tg0 + 16 * it2) * 4;
                float nv[4][8];
#pragma unroll
                for (int j = 0; j < 4; ++j) {
                    const f32x2 mr = *(const LAS f32x2*)(murs + (t0 + j) * 2);
                    const float mu = mr[0], rs = mr[1];
                    const u32x4 x = w[it2][j];
                    nv[j][0] = (bflo(x.x) - mu) * rs * g0[0] + b0[0]; nv[j][1] = (bfhi(x.x) - mu) * rs * g0[1] + b0[1];
                    nv[j][2] = (bflo(x.y) - mu) * rs * g0[2] + b0[2]; nv[j][3] = (bfhi(x.y) - mu) * rs * g0[3] + b0[3];
                    nv[j][4] = (bflo(x.z) - mu) * rs * g1[0] + b1[0]; nv[j][5] = (bfhi(x.z) - mu) * rs * g1[1] + b1[1];
                    nv[j][6] = (bflo(x.w) - mu) * rs * g1[2] + b1[2]; nv[j][7] = (bfhi(x.w) - mu) * rs * g1[3] + b1[3];
                }
                const int qp = ((t0 >> 3) ^ (cg8 & 15)) * 16 + ((t0 >> 2) & 1) * 8;
#pragma unroll
                for (int e = 0; e < 8; ++e)
                    *(LAS u32x2*)(lds + (c0 + e) * VTS + qp) = (u32x2){pk2(nv[0][e], nv[1][e]), pk2(nv[2][e], nv[3][e])};
            }
        }
        const int th = wid & 1, ch = wid >> 1;
        u32x2 uu[4][4];
#pragma unroll
        for (int a = 0; a < 4; ++a)
#pragma unroll
            for (int c = 0; c < 4; ++c) uu[a][c] = *(const u32x2*)(Z + (row0 + th * 64 + a * 16 + fr) * ZW + g * 256 + ch * 64 + fq * 4 + c * 16);
        float biasv[4];
#pragma unroll
        for (int a = 0; a < 4; ++a) biasv[a] = bs[g * 128 + th * 64 + a * 16 + fr];
        if (k + 1 < nitems) GMLP_LOAD(item + istep);
        WG_BAR();
        f32x4 acc[4][4];
#pragma unroll
        for (int a = 0; a < 4; ++a)
#pragma unroll
            for (int c = 0; c < 4; ++c) acc[a][c] = (f32x4){0.f, 0.f, 0.f, 0.f};
#pragma unroll
        for (int ks = 0; ks < 4; ++ks) {
            if (32 * ks <= th * 64 + 63) {
                bf16x8 X[4];
#pragma unroll
                for (int c = 0; c < 4; ++c) { const int crow = ch * 64 + c * 16 + fr; X[c] = *(const LAS bf16x8*)(lds + crow * VTS + (((ks * 4 + fq) ^ ((crow >> 3) & 15)) * 16)); }
#pragma unroll
                for (int a = 0; a < 4; ++a) {
                    const int tgl = th * 64 + a * 16;
                    if (32 * ks <= tgl + 15) {
                        const bf16x8 Y = *(const LAS bf16x8*)(lds + WL_OFF + (tgl + fr) * WLS + (ks * 32 + fq * 8) * 2);
#pragma unroll
                        for (int c = 0; c < 4; ++c) acc[a][c] = mfma16(X[c], Y, acc[a][c]);
                    }
                }
            }
        }
#pragma unroll
        for (int a = 0; a < 4; ++a) {
            const int t = th * 64 + a * 16 + fr;
            const float bias = biasv[a];
            bf16_t* ur = Z + (row0 + t) * ZW + g * 256 + ch * 64 + fq * 4;
#pragma unroll
            for (int c = 0; c < 4; ++c) {
                const float r0 = (acc[a][c][0] + bias) * bflo(uu[a][c].x), r1 = (acc[a][c][1] + bias) * bfhi(uu[a][c].x);
                const float r2 = (acc[a][c][2] + bias) * bflo(uu[a][c].y), r3 = (acc[a][c][3] + bias) * bfhi(uu[a][c].y);
                __builtin_nontemporal_store((u32x2){pk2(r0, r1), pk2(r2, r3)}, (u32x2*)(ur + c * 16));
            }
        }
        WG_BAR();
    }
}
#undef GMLP_LOAD

struct Args { const float* in[22]; float* out; unsigned char* ws; };

__device__ __forceinline__ void grid_bar(unsigned* cnt, unsigned target, int wid, int lane) {
    asm volatile("s_waitcnt vmcnt(0) lgkmcnt(0)" ::: "memory");
    __builtin_amdgcn_s_barrier();
    if (wid == 0 && lane == 0) {
        __builtin_amdgcn_fence(__ATOMIC_RELEASE, "agent");
        asm volatile("s_waitcnt vmcnt(0)" ::: "memory");
        __hip_atomic_fetch_add(cnt, 1u, __ATOMIC_RELAXED, __HIP_MEMORY_SCOPE_AGENT);
        while (__hip_atomic_load(cnt, __ATOMIC_RELAXED, __HIP_MEMORY_SCOPE_AGENT) < target) __builtin_amdgcn_s_sleep(16);
        __builtin_amdgcn_fence(__ATOMIC_ACQUIRE, "agent");
        asm volatile("s_waitcnt vmcnt(0)" ::: "memory");
    }
    asm volatile("" ::: "memory");
    __builtin_amdgcn_s_barrier();
    asm volatile("" ::: "memory");
}

__device__ __forceinline__ void convert_phase(LAS unsigned char* lds, const Args& a, unsigned char* ws, int L, int G, int bx, int wid0, int mask, bool inputs) {
    const int wid = opaque_s(wid0), lane = lane_id(), tid = wid * 64 + lane;
    const int gw = bx * 8 + wid, ngw = G * 8;
    int ioff = 0;
    for (int mi = 0; mi < 7; ++mi) {
        if (!((mask >> mi) & 1)) continue;
        const float* W; const float* gain = nullptr; bf16_t* WT; int K, N, kind = 0;
        if (mi == 0) { W = a.in[5] + (size_t)L * D * 2 * FF; gain = a.in[4] + L * D; WT = (bf16_t*)(ws + WS_W1IN); K = D; N = 2 * FF; kind = 1; }
        else if (mi == 1) { W = a.in[6] + (size_t)L * FF * D; WT = (bf16_t*)(ws + WS_W1OUT); K = FF; N = D; }
        else if (mi == 2) { W = a.in[19] + (size_t)L * D * 2 * FF; gain = a.in[18] + L * D; WT = (bf16_t*)(ws + (L == 0 ? WS_W2IN : WS_W2IN1)); K = D; N = 2 * FF; kind = 1; }
        else if (mi == 3) { W = a.in[20] + (size_t)L * FF * D; WT = (bf16_t*)(ws + (L == 0 ? WS_W2OUT : WS_W2OUT1)); K = FF; N = D; }
        else if (mi == 4) { W = a.in[8] + (size_t)L * D * 2048; WT = (bf16_t*)(ws + WS_WKV); K = D; N = 2048; }
        else if (mi == 5) { W = (L == 0) ? a.in[9] : a.in[12]; gain = a.in[7] + L * D; WT = (bf16_t*)(ws + WS_WIN); K = D; N = ZW; kind = (L == 0) ? 2 : 3; }
        else { W = (L == 0) ? a.in[11] : a.in[17]; WT = (bf16_t*)(ws + (L == 0 ? WS_WOUT : WS_WOUT1)); K = (L == 0) ? 2048 : 3072; N = D; }
        const int roff = ioff % ngw; const int gwm = (gw >= roff) ? gw - roff : gw + ngw - roff;
        transpose_mat(lds, W, gain, WT, K, N, kind, gwm, ngw, wid, lane);
        ioff += (K / 64) * (N / 32);
    }
    if (inputs) {
        float* part = (float*)(ws + WS_PART); bf16_t* xb = (bf16_t*)(ws + WS_XB);
        bf16_t* Wm = (bf16_t*)(ws + WS_WM); bf16_t* memn = (bf16_t*)(ws + WS_MEMN);
        {
            f32x4 v[4][4];
            int r4 = gw * 4;
            if (r4 < M) {
#pragma unroll
                for (int q = 0; q < 4; ++q)
#pragma unroll
                    for (int j = 0; j < 4; ++j) v[q][j] = *((const f32x4*)(a.in[0] + (size_t)(r4 + q) * D) + 64 * j + lane);
            }
            for (; r4 < M; r4 += ngw * 4) {
                f32x4 w[4][4];
#pragma unroll
                for (int q = 0; q < 4; ++q)
#pragma unroll
                    for (int j = 0; j < 4; ++j) w[q][j] = v[q][j];
                const int rn = r4 + ngw * 4;
                if (rn < M) {
#pragma unroll
                    for (int q = 0; q < 4; ++q)
#pragma unroll
                        for (int j = 0; j < 4; ++j) v[q][j] = *((const f32x4*)(a.in[0] + (size_t)(rn + q) * D) + 64 * j + lane);
                }
#pragma unroll
                for (int q = 0; q < 4; ++q) {
                    float ss = 0.f;
#pragma unroll
                    for (int j = 0; j < 4; ++j) { const f32x4 x = w[q][j]; ss += (x[0] * x[0] + x[1] * x[1]) + (x[2] * x[2] + x[3] * x[3]);
                        *((u32x2*)(xb + (size_t)(r4 + q) * D) + 64 * j + lane) = (u32x2){pk2(x[0], x[1]), pk2(x[2], x[3])}; }
                    ss = wave_sum(ss, lane);
                    if (lane < 16) part[(size_t)(r4 + q) * 16 + lane] = (lane == 0) ? ss : 0.f;
                }
            }
        }
        for (int r = gw; r < MROWS; r += ngw) {
            const f32x4* xr = (const f32x4*)(a.in[1] + (size_t)r * D) + lane;
            const f32x4* gr = (const f32x4*)(a.in[2]) + lane;
            f32x4 v[4]; float ss = 0.f;
#pragma unroll
            for (int j = 0; j < 4; ++j) { v[j] = xr[64 * j]; ss += (v[j][0] * v[j][0] + v[j][1] * v[j][1]) + (v[j][2] * v[j][2] + v[j][3] * v[j][3]); }
            ss = wave_sum(ss, lane);
            const float rs = 1.0f / sqrtf(ss * (1.0f / 1024.0f) + EPS);
#pragma unroll
            for (int j = 0; j < 4; ++j) { const f32x4 gg = gr[64 * j];
                *((u32x2*)(memn + (size_t)r * D) + 64 * j + lane) = (u32x2){pk2(v[j][0] * rs * gg[0], v[j][1] * rs * gg[1]), pk2(v[j][2] * rs * gg[2], v[j][3] * rs * gg[3])}; }
        }
        for (int i = bx * NTHREADS + tid; i < 8 * 128 * 128; i += G * NTHREADS) {
            const int s = i & 127, t = (i >> 7) & 127;
            Wm[i] = (s <= t) ? (bf16_t)(pk2(a.in[15][i], 0.f) & 0xffffu) : (bf16_t)0;
        }
    }
}

__global__ void __launch_bounds__(NTHREADS, 2) mega_fwd(Args a) {
    extern __shared__ __attribute__((aligned(16))) unsigned char lds_raw[];
    LAS unsigned char* lds = (LAS unsigned char*)lds_raw;
    const int G = gridDim.x, bx = blockIdx.x;
    const int wid0 = __builtin_amdgcn_readfirstlane(threadIdx.x >> 6);
    unsigned* barcnt = (unsigned*)(a.ws + WS_CTL);

    cg::this_grid().sync();

    const int gx = bx & 7, gj = bx >> 3;
    unsigned* grpcnt = barcnt + 64 * (1 + gx);
    unsigned ng = 0, nl = 0;

    for (int ph = 0; ph < 16; ++ph) {
        if (ph == 8) continue;
        const int L = ph >> 3, k = ph & 7;
        unsigned char* ws = a.ws; asm volatile("" : "+s"(ws));
        float* part = (float*)(ws + WS_PART); float* stat = (float*)(ws + WS_STAT);
        bf16_t* xb = (bf16_t*)(ws + WS_XB); bf16_t* Z = (bf16_t*)(ws + WS_Z); bf16_t* HID = Z;
        bf16_t* Kb = (bf16_t*)(ws + WS_KB); bf16_t* Vt = (bf16_t*)(ws + WS_VT);
        if (k == 0) {
            convert_phase(lds, a, ws, 0, G, bx, wid0, 0x7f, true);
        } else if (k == 1 || k == 6) {
            {
                pg8::Gemm g{xb, (const bf16_t*)(ws + (k == 1 ? WS_W1IN : (L == 0 ? WS_W2IN : WS_W2IN1))), D, D, D}; pg8::StaticOrder S; S.init(M, 2 * FF, G, bx);
                pg8::EpiSwiglu E{HID, part};
                pg8::gemm_phase<pg8::EpiSwiglu, pg8::StaticOrder, true>(lds, g, S, E, wid0);
            }
            if (k == 1) {
                pg8::Gemm g{(const bf16_t*)(ws + WS_MEMN), (const bf16_t*)(ws + WS_WKV), D, D, D};
                pg8::FixedUnit S; S.has = (gj >= 16); S.u.pm = 2 * gx + ((gj >> 3) & 1); S.u.pn = gj & 7;
                pg8::EpiPlain E{Kb, 2048};
                pg8::gemm_phase<pg8::EpiPlain, pg8::FixedUnit, true>(lds, g, S, E, wid0);
            }
        } else if (k == 2 || k == 5 || k == 7) {
            const int Kc = (k == 5) ? ((L == 0) ? 2048 : 3072) : FF;
            const bf16_t* A = (k == 5) ? Z : HID; const int lda = ZW;
            const bf16_t* Bt = (const bf16_t*)(ws + (k == 2 ? WS_W1OUT : (k == 5 ? (L == 0 ? WS_WOUT : WS_WOUT1) : (L == 0 ? WS_W2OUT : WS_W2OUT1))));
            pg8::Gemm g{A, Bt, lda, Kc, Kc}; pg8::StaticOrder S; S.init(M, D, G, bx);
            pg8::EpiResid E{(ph == 2) ? a.in[0] : nullptr, xb, part, (k == 5) ? 1.0f : 0.5f};
            pg8::gemm_phase<pg8::EpiResid, pg8::StaticOrder, true>(lds, g, S, E, wid0);
            if (k == 2) {
                const int lane = lane_id(), tid = opaque_s(wid0) * 64 + lane;
                unsigned vv[4][8];
#pragma unroll
                for (int q = 0; q < 4; ++q) {
                    const int i = gj * NTHREADS + tid + q * 32 * NTHREADS;
                    const int d = i & 255, mc = (i >> 8) & 31, bh = 8 * gx + (i >> 13);
                    const bf16_t* src = Kb + (size_t)((bh >> 2) * 256 + mc * 8) * 2048 + 1024 + (bh & 3) * 256 + d;
#pragma unroll
                    for (int e = 0; e < 8; ++e) vv[q][e] = src[(size_t)e * 2048];
                }
#pragma unroll
                for (int q = 0; q < 4; ++q) {
                    const int i = gj * NTHREADS + tid + q * 32 * NTHREADS;
                    const int d = i & 255, mc = (i >> 8) & 31, bh = 8 * gx + (i >> 13);
                    *(u32x4*)(Vt + ((size_t)bh * 256 + d) * 256 + mc * 8) = (u32x4){vv[q][0] | (vv[q][1] << 16), vv[q][2] | (vv[q][3] << 16), vv[q][4] | (vv[q][5] << 16), vv[q][6] | (vv[q][7] << 16)};
                }
            }
        } else if (k == 3) {
            pg8::Gemm g{xb, (const bf16_t*)(ws + WS_WIN), D, D, D}; pg8::StaticOrder S; S.init(M, ZW, G, bx);
            pg8::EpiZ E{Z, part, stat, L};
            pg8::gemm_phase<pg8::EpiZ, pg8::StaticOrder, true>(lds, g, S, E, wid0);
        } else {
            bf16_t* Zx = Z + ((L == 0) ? 1024 : 2048);
            if (L == 0) {
                if (gj < 16) hgrn_item(lds, Z, a.in[3], a.in[10], 2 * gx + (gj >> 3), gj & 7, wid0);
                else {
                    for (int u = gj - 16; u < 64; u += 16) attn_unit(lds, Zx, Kb, Vt, (2 * gx + (u >> 5)) * 32 + (u & 31), wid0);
                    convert_phase(lds, a, ws, 1, 128, gx * 16 + (gj - 16), wid0, 0x7f, false);
                }
            } else {
                gmlp_items(lds, Z, stat, a.in[13], a.in[14], (const bf16_t*)(ws + WS_WM), a.in[16], (2 * gx) * 128 + gj, 32, 8, wid0);
                for (int u = gj; u < 64; u += 32) attn_unit(lds, Zx, Kb, Vt, (2 * gx + (u >> 5)) * 32 + (u & 31), wid0);
            }
        }
        if (ph == 0 || ph == 3 || ph == 7) { ++ng; grid_bar(barcnt, ng * (unsigned)G, opaque_s(wid0), lane_id()); }
        else { ++nl; grid_bar(grpcnt, nl * 32u, opaque_s(wid0), lane_id()); }
    }
    {
        const int wid = opaque_s(wid0), lane = lane_id();
        const float* part = (const float*)(a.ws + WS_PART); float* xres = a.out; const bf16_t* xbf = (const bf16_t*)(a.ws + WS_XB);
        const f32x4* gr = (const f32x4*)(a.in[21]) + lane;
        f32x4 gg[4];
#pragma unroll
        for (int j = 0; j < 4; ++j) gg[j] = gr[64 * j];
        for (int r0 = 4096 * gx + gj * 8 + wid; r0 < 4096 * (gx + 1); r0 += 1024) {
            f32x4 pp[4]; u32x2 xv[4][4];
#pragma unroll
            for (int q = 0; q < 4; ++q) {
                const int r = r0 + 256 * q;
                pp[q] = *((const f32x4*)(part + (size_t)r * 16) + (lane & 3));
#pragma unroll
                for (int j = 0; j < 4; ++j) xv[q][j] = *((const u32x2*)(xbf + (size_t)r * D) + lane + 64 * j);
            }
#pragma unroll
            for (int q = 0; q < 4; ++q) {
                const int r = r0 + 256 * q;
                float sm = (pp[q][0] + pp[q][1]) + (pp[q][2] + pp[q][3]);
                sm += shx(sm, 1, lane); sm += shx(sm, 2, lane);
                const float rs = __builtin_amdgcn_rsqf(sm * (1.0f / 1024.0f) + EPS);
                f32x4* xr = (f32x4*)(xres + (size_t)r * D) + lane;
#pragma unroll
                for (int j = 0; j < 4; ++j) { const u32x2 v = xv[q][j]; xr[64 * j] = (f32x4){bflo(v.x) * rs * gg[j][0], bfhi(v.x) * rs * gg[j][1], bflo(v.y) * rs * gg[j][2], bfhi(v.y) * rs * gg[j][3]}; }
            }
        }
    }
}

extern "C" void kernel_launch(void* const* d_in, const int* in_sizes, int n_in, void* d_out, int out_size, void* d_ws, size_t ws_size, hipStream_t stream) {
    static int grid = 0;
    if (grid == 0) {
        if (n_in != 22 || out_size != M * D || ws_size < WS_END) { fprintf(stderr, "kernel_launch: unexpected shapes (n_in %d out %d ws %zu)\n", n_in, out_size, ws_size); grid = -1; return; }
        int dev = 0, cus = 0, per_cu = 0;
        (void)hipGetDevice(&dev);
        (void)hipDeviceGetAttribute(&cus, hipDeviceAttributeMultiprocessorCount, dev);
        if (hipFuncSetAttribute((const void*)mega_fwd, hipFuncAttributeMaxDynamicSharedMemorySize, LDS_BYTES) != hipSuccess) { fprintf(stderr, "kernel_launch: hipFuncSetAttribute failed\n"); grid = -1; return; }
        if (hipOccupancyMaxActiveBlocksPerMultiprocessor(&per_cu, (const void*)mega_fwd, NTHREADS, LDS_BYTES) != hipSuccess || per_cu < 1) { fprintf(stderr, "kernel_launch: occupancy query gave %d\n", per_cu); per_cu = 1; }
        (void)hipGetLastError();
        grid = cus * per_cu;
        if (grid != 256) { fprintf(stderr, "kernel_launch: this kernel is built for 256 co-resident workgroups (got %d x %d)\n", cus, per_cu); if (grid < 256) { grid = -1; return; } grid = 256; }
    }
    if (grid < 0) return;
    if (hipMemsetAsync((char*)d_ws + WS_CTL, 0, 4096, stream) != hipSuccess) { fprintf(stderr, "kernel_launch: memset failed\n"); return; }
    Args a{};
    for (int i = 0; i < 22; ++i) a.in[i] = (const float*)d_in[i];
    a.out = (float*)d_out; a.ws = (unsigned char*)d_ws;
    void* args[] = {&a};
    hipError_t e = hipLaunchCooperativeKernel((const void*)mega_fwd, dim3(grid), dim3(NTHREADS), args, LDS_BYTES, stream);
    if (e != hipSuccess) fprintf(stderr, "kernel_launch: cooperative launch failed: %s (grid %d)\n", hipGetErrorString(e), grid);
}
```
